# Optimizing an MI355X kernel written in HIP

```python
import math
import jax, jax.numpy as jnp
from jax import lax
import numpy as np

D_MODEL = 1024
BATCH = 2
SEQ = 16384
DEPTH = 4

CHUNK = 64
Q_BLOCK = 128
CONV_K = 4
EPS = 1e-6

GLA_HEADS = 4
GLA_DK = 64
GLA_DV = 128
GLA_QK = GLA_HEADS * GLA_DK
GLA_WIDTH = GLA_HEADS * GLA_DV
GLA_GATE_RANK = 16
GLA_GATE_TEMP = 16.0

DIFF_HEADS = 4
DIFF_DH = 64
DIFF_DV = 2 * DIFF_DH
DIFF_QK = DIFF_HEADS * 2 * DIFF_DH
DIFF_WIDTH = DIFF_HEADS * DIFF_DV

MIX_WIDTH = GLA_WIDTH + DIFF_WIDTH
GLA_CONV_WIDTH = 2 * GLA_QK + GLA_WIDTH
SPLIT_SIZES = (GLA_QK, GLA_QK, GLA_WIDTH, GLA_GATE_RANK, GLA_WIDTH,
               DIFF_QK, DIFF_QK, DIFF_WIDTH, DIFF_WIDTH)
IN_WIDTH = 2 * GLA_QK + 2 * GLA_WIDTH + GLA_GATE_RANK + 2 * DIFF_QK + 2 * DIFF_WIDTH

kernel_name = "hybrid_gla_diffattn_adaln_trunk"


def rms_norm(x, g):
    xf = x.astype(jnp.float32)
    y = xf * lax.rsqrt(jnp.mean(xf * xf, axis=-1, keepdims=True) + EPS)
    return (y * g.astype(jnp.float32)).astype(x.dtype)


def split_columns(p):
    idx = np.cumsum(np.array(SPLIT_SIZES))[:-1].tolist()
    return jnp.split(p, idx, axis=-1)


def causal_depthwise_conv(u, w):
    S = u.shape[1]
    up = jnp.pad(u, ((0, 0), (CONV_K - 1, 0), (0, 0)))
    out = up[:, 0:S] * w[0]
    for j in range(1, CONV_K):
        out = out + up[:, j:j + S] * w[j]
    return out


def gla_branch(q, k, v, glr, z, w_gk, b_gk, g_out):
    B, S, _ = q.shape
    nc = S // CHUNK
    f32 = jnp.float32
    q = q.astype(f32).reshape(B, nc, CHUNK, GLA_HEADS, GLA_DK) * (GLA_DK ** -0.5)
    k = k.astype(f32).reshape(B, nc, CHUNK, GLA_HEADS, GLA_DK)
    v = v.astype(f32).reshape(B, nc, CHUNK, GLA_HEADS, GLA_DV)
    log_a = jax.nn.log_sigmoid((glr @ w_gk + b_gk).astype(f32)) / GLA_GATE_TEMP
    log_a = log_a.reshape(B, nc, CHUNK, GLA_HEADS, GLA_DK)
    b = jnp.cumsum(log_a, axis=2)
    b_end = b[:, :, -1]
    k_dec = k * jnp.exp(b_end[:, :, None] - b)
    u = jnp.einsum('bnchk,bnchv->nbhkv', k_dec, v)
    a = jnp.exp(b_end).transpose(1, 0, 2, 3)

    def step(state, inp):
        a_c, u_c = inp
        state = a_c[..., None] * state + u_c
        return state, state

    s0 = jnp.zeros((B, GLA_HEADS, GLA_DK, GLA_DV), f32)
    _, states = lax.scan(step, s0, (a, u))
    o = jnp.einsum('bnchk,nbhkv->bnchv', q, states)
    o = rms_norm(o, g_out).reshape(B, S, GLA_WIDTH)
    return o * jax.nn.silu(z.astype(f32))


def diff_branch(q, k, v, z, qn_g, kn_g, lam, lam_init, g_out):
    B, S, _ = q.shape
    f32 = jnp.float32
    q = rms_norm(q.reshape(B, S, DIFF_HEADS, 2, DIFF_DH), qn_g) * (DIFF_DH ** -0.5)
    k = rms_norm(k.reshape(B, S, DIFF_HEADS, 2, DIFF_DH), kn_g)
    v = v.astype(f32).reshape(B, S, DIFF_HEADS, DIFF_DV)
    key_chunk = jnp.arange(S) // CHUNK
    nb = S // Q_BLOCK
    qb = q.reshape(B, nb, Q_BLOCK, DIFF_HEADS, 2, DIFF_DH).transpose(1, 0, 2, 3, 4, 5)
    q_chunk = key_chunk.reshape(nb, Q_BLOCK)

    def block(args):
        qi, qc = args
        s = jnp.einsum('bqhmd,bkhmd->bhmqk', qi, k).astype(f32)
        mask = key_chunk[None, :] <= qc[:, None]
        s = jnp.where(mask, s, -jnp.inf)
        p = jax.nn.softmax(s, axis=-1)
        attn = p[:, :, 0] - lam * p[:, :, 1]
        return jnp.einsum('bhqk,bkhe->bqhe', attn, v)

    o = lax.map(block, (qb, q_chunk))
    o = o.transpose(1, 0, 2, 3, 4).reshape(B, S, DIFF_HEADS, DIFF_DV)
    o = rms_norm(o, g_out) * (1.0 - lam_init)
    return o.reshape(B, S, DIFF_WIDTH) * jax.nn.silu(z.astype(f32))


def setup_inputs(seed: int = 0) -> dict:
    key = jax.random.key(seed)
    ks = jax.random.split(key, 18)
    f32 = jnp.float32
    L, D = DEPTH, D_MODEL
    n = lambda k, s, sc: (jax.random.normal(k, s, f32) * sc)
    return {
        "x": n(ks[0], (BATCH, SEQ, D), 1.0),
        "c": n(ks[1], (BATCH, D), 1.0),
        "w_ada": n(ks[2], (L, D, 3 * D), 0.5 * D ** -0.5),
        "b_ada": n(ks[3], (L, 3 * D), 0.02),
        "norm_g": 1.0 + n(ks[4], (L, D), 0.02),
        "w_in": n(ks[5], (L, D, IN_WIDTH), D ** -0.5),
        "conv_w": n(ks[6], (L, CONV_K, GLA_CONV_WIDTH), CONV_K ** -0.5),
        "w_gk": n(ks[7], (L, GLA_GATE_RANK, GLA_QK), GLA_GATE_RANK ** -0.5),
        "b_gk": n(ks[8], (L, GLA_QK), 0.1),
        "gla_norm_g": 1.0 + n(ks[9], (L, GLA_DV), 0.02),
        "qn_g": 1.0 + n(ks[10], (L, DIFF_DH), 0.02),
        "kn_g": 1.0 + n(ks[11], (L, DIFF_DH), 0.02),
        "lam_q1": n(ks[12], (L, DIFF_DH), 0.1),
        "lam_k1": n(ks[13], (L, DIFF_DH), 0.1),
        "lam_q2": n(ks[14], (L, DIFF_DH), 0.1),
        "lam_k2": n(ks[15], (L, DIFF_DH), 0.1),
        "diff_norm_g": 1.0 + n(ks[16], (L, DIFF_DV), 0.02),
        "w_out": n(ks[17], (L, MIX_WIDTH, D), MIX_WIDTH ** -0.5),
    }


def reference(x, c, w_ada, b_ada, norm_g, w_in, conv_w, w_gk, b_gk, gla_norm_g,
              qn_g, kn_g, lam_q1, lam_k1, lam_q2, lam_k2, diff_norm_g, w_out):
    f32 = jnp.float32
    c_act = jax.nn.silu(c)
    for l in range(DEPTH):
        mod = c_act @ w_ada[l] + b_ada[l]
        shift, scale, gate = jnp.split(mod, 3, axis=-1)
        h = rms_norm(x, norm_g[l]) * (1.0 + scale[:, None]) + shift[:, None]
        proj = h @ w_in[l]
        gq, gk, gv, glr, gz, dq, dk, dv, dz = split_columns(proj)
        gqkv = jax.nn.silu(causal_depthwise_conv(jnp.concatenate([gq, gk, gv], axis=-1), conv_w[l]))
        gq, gk, gv = jnp.split(gqkv, [GLA_QK, 2 * GLA_QK], axis=-1)
        o_gla = gla_branch(gq, gk, gv, glr, gz, w_gk[l], b_gk[l], gla_norm_g[l])
        lam_init = 0.8 - 0.6 * math.exp(-0.3 * l)
        lam = (jnp.exp(jnp.sum(lam_q1[l].astype(f32) * lam_k1[l].astype(f32)))
               - jnp.exp(jnp.sum(lam_q2[l].astype(f32) * lam_k2[l].astype(f32))) + lam_init)
        o_diff = diff_branch(dq, dk, dv, dz, qn_g[l], kn_g[l], lam, lam_init, diff_norm_g[l])
        y = jnp.concatenate([o_gla, o_diff], axis=-1).astype(x.dtype) @ w_out[l]
        x = x + gate[:, None] * y
    return x
```

```cpp
#include <hip/hip_runtime.h>
#include <hip/hip_bf16.h>
#include <hip/hip_cooperative_groups.h>
#include <cstdio>
#include <cstdint>
namespace cg = cooperative_groups;

#define DI __device__ __forceinline__
typedef unsigned short bfu;
using bf16x8 = __attribute__((ext_vector_type(8))) short;
using f32x16 = __attribute__((ext_vector_type(16))) float;
using u32x4  = __attribute__((ext_vector_type(4))) unsigned;
#define MFMA32(a, b, c) __builtin_amdgcn_mfma_f32_32x32x16_bf16((a), (b), (c), 0, 0, 0)

constexpr int D = 1024, BATCH = 2, SEQ = 16384, DEPTH = 4, T = BATCH * SEQ;
constexpr int NCH = SEQ / 64;
constexpr int INW = 3600, NP = 3840;
constexpr int C_GQ = 0, C_GK = 256, C_GV = 512, C_GZ = 1024, C_DQ = 1536, C_DK = 2048, C_DV = 2560, C_DZ = 3072, C_GLR = 3584;
constexpr float EPS = 1e-6f;
constexpr float LOG2E = 1.4426950408889634f;
constexpr int NT = 512;
constexpr int LDS_BYTES = 139264;

constexpr size_t WS_WINT = 0;
constexpr size_t WS_WOUTT = WS_WINT + (size_t)DEPTH * NP * D * 2;
constexpr size_t WS_MODP = WS_WOUTT + (size_t)DEPTH * D * D * 2;
constexpr size_t WS_MOD = WS_MODP + (size_t)DEPTH * 8 * 2 * 3072 * 4;
constexpr size_t WS_LAM = WS_MOD + (size_t)DEPTH * 2 * 3072 * 4;
constexpr size_t WS_H = WS_LAM + 256;
constexpr size_t WS_PROJ = WS_H + (size_t)T * D * 2;
constexpr size_t WS_U = WS_PROJ + (size_t)T * NP * 2;
constexpr size_t WS_A = WS_U + (size_t)BATCH * NCH * 4 * 8192 * 2;
constexpr size_t WS_QS = WS_A + (size_t)BATCH * NCH * 256 * 4;
constexpr size_t WS_QN = WS_QS + (size_t)T * 256 * 2;
constexpr size_t WS_KN = WS_QN + (size_t)T * 512 * 2;
constexpr size_t WS_VT = WS_KN + (size_t)T * 512 * 2;
constexpr size_t WS_BAR = WS_VT + (size_t)T * 512 * 2;
constexpr size_t WS_END = WS_BAR + 16384;

struct Params {
  const float *x, *c, *w_ada, *b_ada, *norm_g, *w_in, *conv_w, *w_gk, *b_gk, *gla_g, *qn_g, *kn_g, *lq1, *lk1, *lq2, *lk2, *diff_g, *w_out;
  float* out; unsigned char* ws;
  float lam_init[4];
  int ph_lo, ph_hi;
};

DI int opaque_tid() { int t = threadIdx.x; asm volatile("" : "+v"(t)); return t; }
DI float bf2f(unsigned u) { return __uint_as_float(u << 16); }
typedef __bf16 bf16x2_t __attribute__((ext_vector_type(2)));
typedef float f32x2_t __attribute__((ext_vector_type(2)));
DI unsigned cvtpk(float lo, float hi) { f32x2_t v = {lo, hi}; bf16x2_t r = __builtin_convertvector(v, bf16x2_t); return __builtin_bit_cast(unsigned, r); }
DI bfu f2bf(float x) { return (bfu)(cvtpk(x, 0.f) & 0xffffu); }
DI float silu_f(float x) { return x * __builtin_amdgcn_rcpf(1.f + __expf(-x)); }
DI int crow(int reg, int h) { return (reg & 3) + 8 * (reg >> 2) + 4 * h; }
DI int pi_row(int r) { return (r & ~12) | ((r & 4) << 1) | ((r & 8) >> 1); }
DI float wave_sum(float v) {
#pragma unroll
  for (int o = 32; o >= 1; o >>= 1) v += __shfl_xor(v, o);
  return v;
}

DI void glds16(const void* g, unsigned lds_base) {
  unsigned sv; asm volatile("s_mov_b32 %0, m0\n\ts_mov_b32 m0, %2\n\ts_nop 0\n\tglobal_load_lds_dwordx4 %1, off\n\ts_mov_b32 m0, %0" : "=&s"(sv) : "v"(g), "s"(lds_base) : "memory"); }
#define WAIT_BAR0() asm volatile("s_waitcnt vmcnt(0) lgkmcnt(0)\n\ts_barrier" ::: "memory")


DI void p0_prologue(const Params& p, char* lds) {
  const int tid = opaque_tid(), lane = tid & 63;
  const int wave = __builtin_amdgcn_readfirstlane(tid >> 6);
  bfu* WinT = (bfu*)(p.ws + WS_WINT); bfu* WoutT = (bfu*)(p.ws + WS_WOUTT);
  float* lamv = (float*)(p.ws + WS_LAM);
  constexpr int N_MOD = DEPTH * 48;
  {
    float* red = (float*)lds;
    for (int it = blockIdx.x; it < N_MOD + 1; it += gridDim.x) {
      if (it < N_MOD) {
        const int l = it / 48, jb = it % 48;
        const int j = lane, ks = wave;
        float a0 = 0.f, a1 = 0.f;
        const float* wp = p.w_ada + (size_t)(l * 1024 + ks * 128) * 3072 + jb * 64 + j;
        const float* cp = p.c + ks * 128;
#pragma unroll 32
        for (int k = 0; k < 128; ++k) { const float w = wp[(size_t)k * 3072]; a0 += silu_f(cp[k]) * w; a1 += silu_f(cp[1024 + k]) * w; }
        red[(ks * 2 + 0) * 64 + j] = a0; red[(ks * 2 + 1) * 64 + j] = a1;
        __syncthreads();
        if (tid < 128) {
          const int b = tid >> 6;
          float acc = p.b_ada[l * 3072 + jb * 64 + j];
#pragma unroll
          for (int q = 0; q < 8; ++q) acc += red[(q * 2 + b) * 64 + j];
          ((float*)(p.ws + WS_MOD))[(l * 2 + b) * 3072 + jb * 64 + j] = acc;
        }
        __syncthreads();
      } else if (tid < 64) {
        for (int l = 0; l < DEPTH; ++l) {
          float s1 = p.lq1[l * 64 + tid] * p.lk1[l * 64 + tid], s2 = p.lq2[l * 64 + tid] * p.lk2[l * 64 + tid];
          s1 = wave_sum(s1); s2 = wave_sum(s2);
          if (tid == 0) lamv[l] = expf(s1) - expf(s2) + p.lam_init[l];
        }
      }
    }
  }
  {
    constexpr int N_IN = DEPTH * 16 * 57, N_OUT = DEPTH * 16 * 16;
    float* tile = (float*)(lds + wave * 16640);
    for (int it = blockIdx.x * 8 + wave; it < N_IN + N_OUT; it += gridDim.x * 8) {
      const bool isin = it < N_IN;
      int l, kt, nt;
      if (isin) { l = it / (16 * 57); int rr = it % (16 * 57); nt = rr / 16; kt = rr % 16; }
      else { int r2 = it - N_IN; l = r2 / 256; int rr = r2 % 256; nt = rr / 16; kt = rr % 16; }
      const int k0 = kt * 64, n0 = nt * 64;
      const int np = n0 + lane;
      const int on = np < 1024 ? np : (np < 3584 ? np + 16 : (np < 3600 ? np - 3584 + 1024 : -1));
      const float* srcp = isin ? (p.w_in + (size_t)(l * 1024 + k0) * INW + (on >= 0 ? on : 0)) : (p.w_out + (size_t)(l * 1024 + k0) * 1024 + n0 + lane);
      const size_t pitch = isin ? INW : 1024;
      const bool live = !isin || on >= 0;
      float v[64];
#pragma unroll
      for (int kk = 0; kk < 64; ++kk) v[kk] = live ? srcp[(size_t)kk * pitch] : 0.f;
      asm volatile("s_waitcnt lgkmcnt(0)" ::: "memory");
#pragma unroll
      for (int kk = 0; kk < 64; ++kk) tile[kk * 65 + lane] = v[kk];
      asm volatile("s_waitcnt lgkmcnt(0)" ::: "memory");
#pragma unroll
      for (int q = 0; q < 8; ++q) {
        const int nn = q * 8 + (lane >> 3), kc = lane & 7;
        const float* tp = tile + (kc * 8) * 65 + nn;
        uint4 o; o.x = cvtpk(tp[0], tp[65]); o.y = cvtpk(tp[130], tp[195]); o.z = cvtpk(tp[260], tp[325]); o.w = cvtpk(tp[390], tp[455]);
        bfu* dst = isin ? (WinT + ((size_t)l * NP + n0 + nn) * 1024 + k0 + kc * 8) : (WoutT + ((size_t)l * 1024 + n0 + nn) * 1024 + k0 + kc * 8);
        *(uint4*)dst = o;
      }
    }
  }
}

DI void phase_norm(const Params& p, int l, const float* xin) {
  const int tid = opaque_tid(), lane = tid & 63, wave = tid >> 6;
  const float* g = p.norm_g + l * 1024; const float* md = (const float*)(p.ws + WS_MOD) + l * 6144;
  bfu* hb = (bfu*)(p.ws + WS_H);
  for (int r0 = (blockIdx.x * 8 + wave) * 16; r0 < T; r0 += gridDim.x * 8 * 16) {
    const int b = r0 >> 14;
    float4 ga[4], sh[4];
#pragma unroll
    for (int i = 0; i < 4; ++i) {
      const int k = (lane + 64 * i) * 4;
      const float4 g4 = *(const float4*)(g + k), sc = *(const float4*)(md + b * 3072 + 1024 + k);
      sh[i] = *(const float4*)(md + b * 3072 + k);
      ga[i].x = g4.x * (1.f + sc.x); ga[i].y = g4.y * (1.f + sc.y); ga[i].z = g4.z * (1.f + sc.z); ga[i].w = g4.w * (1.f + sc.w);
    }
#pragma unroll 1
    for (int rg = 0; rg < 16; rg += 4) {
      float4 v[4][4];
#pragma unroll
      for (int q = 0; q < 4; ++q) {
        const float4* xr = (const float4*)(xin + (size_t)(r0 + rg + q) * 1024);
#pragma unroll
        for (int i = 0; i < 4; ++i) v[q][i] = xr[lane + 64 * i];
      }
#pragma unroll
      for (int q = 0; q < 4; ++q) {
        float ss = 0.f;
#pragma unroll
        for (int i = 0; i < 4; ++i) ss += v[q][i].x * v[q][i].x + v[q][i].y * v[q][i].y + v[q][i].z * v[q][i].z + v[q][i].w * v[q][i].w;
        ss = wave_sum(ss);
        const float rstd = rsqrtf(ss * (1.f / 1024.f) + EPS);
#pragma unroll
        for (int i = 0; i < 4; ++i) {
          const int k = (lane + 64 * i) * 4;
          const float o0 = v[q][i].x * rstd * ga[i].x + sh[i].x, o1 = v[q][i].y * rstd * ga[i].y + sh[i].y;
          const float o2 = v[q][i].z * rstd * ga[i].z + sh[i].z, o3 = v[q][i].w * rstd * ga[i].w + sh[i].w;
          uint2 o; o.x = cvtpk(o0, o1); o.y = cvtpk(o2, o3);
          *(uint2*)(hb + (size_t)(r0 + rg + q) * 1024 + k) = o;
        }
      }
    }
  }
}

DI void tile_map(int idx, int ntn, int& tm, int& tn) {
  const int xcd = idx & 7, li = idx >> 3, g4 = 4 * ntn, g = li / g4, rem = li - g * g4;
  tn = rem >> 2; tm = xcd * 16 + g * 4 + (rem & 3);
}
template <int EPI>
DI void gemm_phase(const Params& p, char* lds, const bfu* __restrict__ A, const bfu* __restrict__ BT, int ntn, int l, const float* xin) {
  const int tid = opaque_tid(), lane = tid & 63, r = lane & 31, h = lane >> 5;
  const int wave = __builtin_amdgcn_readfirstlane(tid >> 6), wm = wave >> 1, wn = wave & 1;
  const int drow = 8 * wave + (lane >> 3);
  const int dsrc = drow * 1024 + (((lane & 7) ^ ((drow >> 1) & 7)) << 3);
  const unsigned lds0 = (unsigned)(uintptr_t)lds;
  const unsigned dd0 = (unsigned)__builtin_amdgcn_readfirstlane(lds0 + wave * 1024);
  const int swz = (r >> 1) & 7;
  const int ntiles = (T / 256) * ntn;
#define DMA_SLAB(Ap, Bp, kk, so) do { const bfu* a_ = (Ap) + dsrc + (kk) * 64; const bfu* b_ = (Bp) + dsrc + (kk) * 64; \
      _Pragma("unroll") for (int q_ = 0; q_ < 4; ++q_) { glds16(a_ + q_ * 64 * 1024, dd0 + (so) + q_ * 8192); glds16(b_ + q_ * 64 * 1024, dd0 + (so) + 32768 + q_ * 8192); } } while (0)
#define SBAR() __builtin_amdgcn_sched_barrier(0)
#define WSYNC() asm volatile("s_waitcnt lgkmcnt(0)" ::: "memory")
#define DMA_PIECE(Ap, Bp, kk, so, pz) glds16((((pz) < 4) ? (Ap) : (Bp)) + dsrc + (kk) * 64 + ((pz) & 3) * 64 * 1024, dd0 + (so) + ((pz) < 4 ? 0 : 32768) + ((pz) & 3) * 8192)
  WAIT_BAR0();
  if ((int)blockIdx.x < ntiles) {
    int tm, tn; tile_map((int)blockIdx.x, ntn, tm, tn);
    DMA_SLAB(A + (size_t)tm * 256 * 1024, BT + (size_t)tn * 256 * 1024, 0, 0);
  }
  WAIT_BAR0();
  for (int tile = blockIdx.x; tile < ntiles; tile += gridDim.x) {
    int tm, tn; tile_map(tile, ntn, tm, tn);
    const int m0 = tm * 256, n0 = tn * 256;
    const int cls = (EPI == 0) ? ((tn >= 6 && tn < 8) ? 1 : (tn >= 8 && tn < 10) ? 2 : (tn >= 10 && tn < 12) ? 3 : 0) : 0;
    const bool vtm = cls == 3;
    const int wA = vtm ? (wave & 1) : wm, wB = vtm ? (wave >> 1) : wn;
    const bfu* Ag = A + (size_t)m0 * 1024;
    const bfu* Bg = BT + (size_t)n0 * 1024;
    f32x16 acc[2][4];
#pragma unroll
    for (int i = 0; i < 2; ++i)
#pragma unroll
      for (int j = 0; j < 4; ++j)
#pragma unroll
        for (int e = 0; e < 16; ++e) acc[i][j][e] = 0.f;
    const bfu* An = Ag; const bfu* Bn = Bg;
    {
      const int nt_ = tile + gridDim.x;
      if (nt_ < ntiles) { int tm2, tn2; tile_map(nt_, ntn, tm2, tn2); An = A + (size_t)tm2 * 256 * 1024; Bn = BT + (size_t)tn2 * 256 * 1024; }
    }
    for (int kt = 0; kt < 16; ++kt) {
      if (kt == 0) asm volatile("s_waitcnt lgkmcnt(0)\n\ts_barrier" ::: "memory"); else WAIT_BAR0();
      const unsigned so = (kt & 1) * 65536;
      const bool dnext = (kt + 1 < 16) || (tile + (int)gridDim.x < ntiles);
      const bfu* dA = (kt + 1 < 16) ? Ag : An; const bfu* dB = (kt + 1 < 16) ? Bg : Bn;
      const int dk = (kt + 1 < 16) ? kt + 1 : 0; const unsigned dso = (kt + 1 < 16) ? 65536 - so : 0;
      const char* sb = lds + so;
      const char* pa = sb + (vtm ? 32768 + (wB * 64 + r) * 128 : (wA * 64 + r) * 128);
      const char* pb = sb + (vtm ? (wA * 128 + r) * 128 : 32768 + (wB * 128 + r) * 128);
      bf16x8 af[2][2], bfr[2][4];
      {
        const unsigned co = (unsigned)((h ^ swz) << 4);
        af[0][0] = *(const bf16x8*)(pa + co); af[0][1] = *(const bf16x8*)(pa + 4096 + co);
#pragma unroll
        for (int j = 0; j < 4; ++j) bfr[0][j] = *(const bf16x8*)(pb + j * 4096 + co);
      }
#pragma unroll
      for (int s = 0; s < 4; ++s) {
        if (s < 3) {
          const unsigned co = (unsigned)((((s + 1) * 2 + h) ^ swz) << 4);
          af[(s + 1) & 1][0] = *(const bf16x8*)(pa + co); af[(s + 1) & 1][1] = *(const bf16x8*)(pa + 4096 + co);
#pragma unroll
          for (int j = 0; j < 4; ++j) bfr[(s + 1) & 1][j] = *(const bf16x8*)(pb + j * 4096 + co);
        }
        SBAR();
#pragma unroll
        for (int i = 0; i < 2; ++i)
#pragma unroll
          for (int j = 0; j < 4; ++j) {
            acc[i][j] = MFMA32(bfr[s & 1][j], af[s & 1][i], acc[i][j]);
            if (s < 2 && (j & 1) && dnext) DMA_PIECE(dA, dB, dk, dso, s * 4 + i * 2 + (j >> 1));
          }
        SBAR();
      }
    }
    WAIT_BAR0();
    if (EPI == 0) {
      char* stg = lds + 65536 + wave * 9216;
#pragma unroll
      for (int jp = 0; jp < 2; ++jp) {
        if (cls == 1 || cls == 2) {
          const float* gg = (cls == 1 ? p.qn_g : p.kn_g) + l * 64;
          const float post = (cls == 1) ? 0.125f * LOG2E : 1.f;
#pragma unroll
          for (int i = 0; i < 2; ++i) {
            float ss = 0.f;
#pragma unroll
            for (int j2 = 0; j2 < 2; ++j2)
#pragma unroll
              for (int e = 0; e < 16; ++e) ss += acc[i][2 * jp + j2][e] * acc[i][2 * jp + j2][e];
            ss += __shfl_xor(ss, 32);
            const float rs = rsqrtf(ss * (1.f / 64.f) + EPS) * post;
#pragma unroll
            for (int j2 = 0; j2 < 2; ++j2)
#pragma unroll
              for (int g = 0; g < 4; ++g) {
                const float4 gv = *(const float4*)(gg + j2 * 32 + 8 * g + 4 * h);
                f32x16& a = acc[i][2 * jp + j2];
                a[4 * g] *= rs * gv.x; a[4 * g + 1] *= rs * gv.y; a[4 * g + 2] *= rs * gv.z; a[4 * g + 3] *= rs * gv.w;
              }
          }
        }
        if (jp) WSYNC();
#pragma unroll
        for (int i = 0; i < 2; ++i)
#pragma unroll
          for (int j2 = 0; j2 < 2; ++j2)
#pragma unroll
            for (int g = 0; g < 4; ++g) {
              const f32x16& a = acc[i][2 * jp + j2];
              uint2 o; o.x = cvtpk(a[4 * g], a[4 * g + 1]); o.y = cvtpk(a[4 * g + 2], a[4 * g + 3]);
              *(uint2*)(stg + (i * 32 + r) * 144 + (j2 * 32 + 8 * g + 4 * h) * 2) = o;
            }
        WSYNC();
        const int nc0 = n0 + wn * 128 + jp * 64;
        bfu* dst; size_t pitch;
        if (cls == 0) { dst = (bfu*)(p.ws + WS_PROJ) + (size_t)(m0 + wm * 64) * NP + nc0; pitch = NP; }
        else if (cls == 3) {
          const int col0 = n0 + wB * 64 - C_DV, bh = (m0 >> 14) * 4 + (col0 >> 7);
          dst = (bfu*)(p.ws + WS_VT) + ((size_t)bh * 128 + (col0 & 127)) * SEQ + ((m0 + wA * 128 + jp * 64) & (SEQ - 1)); pitch = SEQ;
        } else {
          const int col0 = nc0 - (cls == 1 ? C_DQ : C_DK), bh = (m0 >> 14) * 4 + (col0 >> 7);
          dst = (bfu*)(p.ws + (cls == 1 ? WS_QN : WS_KN)) + ((size_t)bh * SEQ + ((m0 + wm * 64) & (SEQ - 1))) * 128 + ((col0 >> 6) & 1) * 64; pitch = 128;
        }
#pragma unroll
        for (int it = 0; it < 8; ++it) {
          const int id = it * 64 + lane, row = id >> 3, c = id & 7;
          const uint4 v = *(const uint4*)(stg + row * 144 + c * 16);
          *(uint4*)(dst + (size_t)row * pitch + c * 8) = v;
        }
      }
    } else {
      char* stg = lds + 65536 + wave * 8704;
      const float* gate = (const float*)(p.ws + WS_MOD) + l * 6144 + (m0 >> 14) * 3072 + 2048;
      float4 xn[8];
#define LOADX(ps_) do { _Pragma("unroll") for (int it = 0; it < 8; ++it) { const int id = it * 64 + lane, row = id >> 4, c = id & 15; \
          xn[it] = *(const float4*)(xin + (size_t)(m0 + wm * 64 + ((ps_) >> 1) * 32 + row) * 1024 + n0 + wn * 128 + ((ps_) & 1) * 64 + c * 4); } } while (0)
      LOADX(0);
#pragma unroll
      for (int ps = 0; ps < 4; ++ps) {
        const int i = ps >> 1, jp = ps & 1;
        float4 xc[8];
#pragma unroll
        for (int it = 0; it < 8; ++it) xc[it] = xn[it];
        if (ps + 1 < 4) LOADX(ps + 1);
        if (ps) WSYNC();
#pragma unroll
        for (int j2 = 0; j2 < 2; ++j2)
#pragma unroll
          for (int g = 0; g < 4; ++g) {
            const f32x16& a = acc[i][2 * jp + j2];
            float4 o; o.x = a[4 * g]; o.y = a[4 * g + 1]; o.z = a[4 * g + 2]; o.w = a[4 * g + 3];
            *(float4*)(stg + r * 272 + (j2 * 32 + 8 * g + 4 * h) * 4) = o;
          }
        WSYNC();
#pragma unroll
        for (int it = 0; it < 8; ++it) {
          const int id = it * 64 + lane, row = id >> 4, c = id & 15;
          const float4 y = *(const float4*)(stg + row * 272 + c * 16);
          const int m = m0 + wm * 64 + i * 32 + row, n = n0 + wn * 128 + jp * 64 + c * 4;
          const float4 xv = xc[it];
          const float4 gv = *(const float4*)(gate + n);
          float4 o; o.x = xv.x + gv.x * y.x; o.y = xv.y + gv.y * y.y; o.z = xv.z + gv.z * y.z; o.w = xv.w + gv.w * y.w;
          *(float4*)(p.out + (size_t)m * 1024 + n) = o;
        }
      }
#undef LOADX
    }
  }
#undef DMA_SLAB
#undef DMA_PIECE
#undef SBAR
#undef WSYNC
  if (EPI == 0) {
    using f32x4 = __attribute__((ext_vector_type(4))) float;
    bfu* proj = (bfu*)(p.ws + WS_PROJ);
    const int quad = lane >> 4, c16 = lane & 15;
    const bfu* wrow = BT + (size_t)(C_GLR + c16) * 1024 + quad * 8;
    for (int rb = blockIdx.x * 8 + wave; rb < T / 16; rb += gridDim.x * 8) {
      const bfu* hrow = A + (size_t)(rb * 16 + c16) * 1024 + quad * 8;
      f32x4 c4 = {0.f, 0.f, 0.f, 0.f}, c5 = {0.f, 0.f, 0.f, 0.f};
#pragma unroll 8
      for (int ks = 0; ks < 32; ks += 2) {
        const bf16x8 wf = *(const bf16x8*)(wrow + ks * 32), wg = *(const bf16x8*)(wrow + ks * 32 + 32);
        const bf16x8 hf = *(const bf16x8*)(hrow + ks * 32), hg = *(const bf16x8*)(hrow + ks * 32 + 32);
        c4 = __builtin_amdgcn_mfma_f32_16x16x32_bf16(wf, hf, c4, 0, 0, 0);
        c5 = __builtin_amdgcn_mfma_f32_16x16x32_bf16(wg, hg, c5, 0, 0, 0);
      }
      c4 += c5;
      uint2 o; o.x = cvtpk(c4[0], c4[1]); o.y = cvtpk(c4[2], c4[3]);
      *(uint2*)(proj + (size_t)(rb * 16 + c16) * NP + C_GLR + quad * 4) = o;
    }
  }
}

DI void prep_gla_load(const Params& p, int b, int c, int hh, uint4& v0, uint4& v1, uint4& v2, uint4& v3, uint4& v4) {
  const int tid = opaque_tid();
  const bfu* proj = (const bfu*)(p.ws + WS_PROJ);
  const int row0 = b * SEQ + c * 64;
#define PGL(i, vi) do { const int id = (i) * NT + tid; vi = make_uint4(0u, 0u, 0u, 0u); \
    if (id < 2144) { const int row = id >> 5, ch = id & 31; \
      const int col = ch < 8 ? (C_GQ + hh * 64 + ch * 8) : (ch < 16 ? (C_GK + hh * 64 + (ch - 8) * 8) : (C_GV + hh * 128 + (ch - 16) * 8)); \
      if (c > 0 || row >= 3) vi = *(const uint4*)(proj + (size_t)(row0 + row - 3) * NP + col); } \
    else if (id < 2272) { const int id2 = id - 2144; vi = *(const uint4*)(proj + (size_t)(row0 + (id2 >> 1)) * NP + C_GLR + (id2 & 1) * 8); } } while (0)
  PGL(0, v0); PGL(1, v1); PGL(2, v2); PGL(3, v3); PGL(4, v4);
#undef PGL
}
DI void prep_gla_item(const Params& p, char* lds, int l, int b, int c, int hh, const uint4& v0, const uint4& v1, const uint4& v2, const uint4& v3, const uint4& v4, int nb, int nc, int nh, bool has_next,
                      uint4& n0, uint4& n1, uint4& n2, uint4& n3, uint4& n4) {
  const int tid = opaque_tid(), lane = tid & 63, r = lane & 31, h = lane >> 5;
  const int wave = __builtin_amdgcn_readfirstlane(tid >> 6);
  char* X = lds;
  char* G = lds + 35376;
  float* kf = (float*)(lds + 37424);
  char* vT = lds + 54832;
  char* kdT = lds + 71216;
  float* tot = (float*)(lds + 79408);
  char* Qs = lds + 81456;
  const bfu* proj = (const bfu*)(p.ws + WS_PROJ);
  bfu* qs = (bfu*)(p.ws + WS_QS); bfu* ub = (bfu*)(p.ws + WS_U); float* ab = (float*)(p.ws + WS_A);
  const int row0 = b * SEQ + c * 64;
  {
#define PGS(i, vi) do { const int id = (i) * NT + tid; if (id < 2144) *(uint4*)(X + (id >> 5) * 528 + (id & 31) * 16) = vi; else if (id < 2272) *(uint4*)(G + (id - 2144) * 16) = vi; } while (0)
    PGS(0, v0); PGS(1, v1); PGS(2, v2); PGS(3, v3); PGS(4, v4);
#undef PGS
  }
  if (has_next) prep_gla_load(p, nb, nc, nh, n0, n1, n2, n3, n4);
  __syncthreads();
  {
    const int j = tid & 255, half = tid >> 8;
    const int col = j < 64 ? (C_GQ + hh * 64 + j) : (j < 128 ? (C_GK + hh * 64 + (j - 64)) : (C_GV + hh * 128 + (j - 128)));
    const float* cw = p.conv_w + (size_t)l * 4 * 1024 + col;
    const float w0 = cw[0], w1 = cw[1024], w2 = cw[2048], w3 = cw[3072];
    const int t0 = half * 32;
    const char* xs = X + t0 * 528 + j * 2;
    float x0 = bf2f(*(const bfu*)(xs)), x1 = bf2f(*(const bfu*)(xs + 528)), x2 = bf2f(*(const bfu*)(xs + 1056));
    float y[32];
#pragma unroll
    for (int tt = 0; tt < 32; ++tt) {
      const float xt = bf2f(*(const bfu*)(xs + (tt + 3) * 528));
      y[tt] = silu_f(w0 * x0 + w1 * x1 + w2 * x2 + w3 * xt);
      x0 = x1; x1 = x2; x2 = xt;
    }
    const int role = __builtin_amdgcn_readfirstlane(j >> 6);
    if (role == 0) {
#pragma unroll
      for (int tt = 0; tt < 32; ++tt) *(bfu*)(Qs + (t0 + tt) * 128 + j * 2) = f2bf(y[tt] * 0.125f);
    } else if (role == 1) {
      float* kr = kf + (j - 64) * 68 + t0;
#pragma unroll
      for (int q4 = 0; q4 < 8; ++q4) { float4 o; o.x = y[4 * q4]; o.y = y[4 * q4 + 1]; o.z = y[4 * q4 + 2]; o.w = y[4 * q4 + 3]; *(float4*)(kr + 4 * q4) = o; }
    } else {
      const int dv = j - 128;
#pragma unroll
      for (int cc = 0; cc < 4; ++cc) {
        uint4 o; o.x = cvtpk(y[8 * cc], y[8 * cc + 1]); o.y = cvtpk(y[8 * cc + 2], y[8 * cc + 3]); o.z = cvtpk(y[8 * cc + 4], y[8 * cc + 5]); o.w = cvtpk(y[8 * cc + 6], y[8 * cc + 7]);
        *(uint4*)(vT + dv * 128 + ((((t0 >> 3) + cc) ^ ((dv >> 1) & 7)) << 4)) = o;
      }
    }
  }
  __syncthreads();
  {
    const int dk = tid & 63, tg = wave;
    float wg[16];
#pragma unroll
    for (int q = 0; q < 16; ++q) wg[q] = p.w_gk[(size_t)(l * 16 + q) * 256 + hh * 64 + dk];
    const float bias = p.b_gk[l * 256 + hh * 64 + dk];
    float cs[8]; float cum = 0.f;
#pragma unroll
    for (int i = 0; i < 8; ++i) {
      const int t = tg * 8 + i;
      const uint4* gp = (const uint4*)(G + t * 32);
      const uint4 g0 = gp[0], g1 = gp[1];
      const unsigned gw[8] = {g0.x, g0.y, g0.z, g0.w, g1.x, g1.y, g1.z, g1.w};
      float z = bias;
#pragma unroll
      for (int q = 0; q < 8; ++q) { z += bf2f(gw[q] & 0xffffu) * wg[2 * q]; z += __uint_as_float(gw[q] & 0xffff0000u) * wg[2 * q + 1]; }
      const float ls = fminf(z, 0.f) - __logf(1.f + __expf(-fabsf(z)));
      cum += ls * (1.f / 16.f);
      cs[i] = cum;
    }
    tot[tg * 64 + dk] = cum;
    __syncthreads();
    float off = 0.f, total = 0.f;
#pragma unroll
    for (int g = 0; g < 8; ++g) { const float tv = tot[g * 64 + dk]; total += tv; if (g < tg) off += tv; }
    float kd[8];
    {
      const float4 ka = *(const float4*)(kf + dk * 68 + tg * 8), kb2 = *(const float4*)(kf + dk * 68 + tg * 8 + 4);
      const float kv[8] = {ka.x, ka.y, ka.z, ka.w, kb2.x, kb2.y, kb2.z, kb2.w};
#pragma unroll
      for (int i = 0; i < 8; ++i) kd[i] = kv[i] * __expf(total - (off + cs[i]));
    }
    {
      const int t = tid >> 3, c = tid & 7;
      *(uint4*)(qs + (size_t)(row0 + t) * 256 + hh * 64 + c * 8) = *(const uint4*)(Qs + t * 128 + c * 16);
    }
    uint4 o; o.x = cvtpk(kd[0], kd[1]); o.y = cvtpk(kd[2], kd[3]); o.z = cvtpk(kd[4], kd[5]); o.w = cvtpk(kd[6], kd[7]);
    *(uint4*)(kdT + dk * 128 + ((tg ^ ((dk >> 1) & 7)) << 4)) = o;
    if (tg == 0) ab[(size_t)(b * NCH + c) * 256 + hh * 64 + dk] = __expf(total);
  }
  __syncthreads();
  {
    const int dvb = wave >> 1, dkb = wave & 1;
    f32x16 acc;
#pragma unroll
    for (int e = 0; e < 16; ++e) acc[e] = 0.f;
    const int swz = (r >> 1) & 7;
#pragma unroll
    for (int s = 0; s < 4; ++s) {
      const unsigned co = (unsigned)(((s * 2 + h) ^ swz) << 4);
      const bf16x8 a = *(const bf16x8*)(vT + (dvb * 32 + r) * 128 + co);
      const bf16x8 bb = *(const bf16x8*)(kdT + (dkb * 32 + r) * 128 + co);
      acc = MFMA32(a, bb, acc);
    }
    bfu* up = ub + (size_t)((b * NCH + c) * 4 + hh) * 8192 + dkb * 32 + r;
#pragma unroll
    for (int e = 0; e < 16; ++e) up[(dvb * 32 + crow(e, h)) * 64] = f2bf(acc[e]);
  }
  __syncthreads();
}

DI void phase_prep(const Params& p, char* lds, int l) {
  constexpr int NIT = BATCH * NCH * 4;
  uint4 a0, a1, a2, a3, a4, b0, b1, b2, b3, b4;
  int it = blockIdx.x;
  if (it < NIT) prep_gla_load(p, (it & 511) >> 8, it & 255, it >> 9, a0, a1, a2, a3, a4);
  for (; it < NIT; it += gridDim.x) {
    const int ty = it >> 9, ch = it & 511, b = ch >> 8, c = ch & 255;
    const int nx = it + gridDim.x; const bool hn = nx < NIT;
    prep_gla_item(p, lds, l, b, c, ty, a0, a1, a2, a3, a4, (nx & 511) >> 8, nx & 255, nx >> 9, hn, b0, b1, b2, b3, b4);
    a0 = b0; a1 = b1; a2 = b2; a3 = b3; a4 = b4;
  }
}

#define XB_TMO      128
#define XB_XCNT(j)  (256  + 64 * (j))
#define XB_XSUB(j)  (1280 + 64 * (j))
#define XB_XGEN(j)  (2304 + 64 * (j))
#define XB_TOP      3328
#define XB_TOPGEN   3392
#define XCD_BAR_WORDS 3456
#define XB_SPIN_CAP (1u << 18)
DI unsigned xb_ld(unsigned* p) { return __hip_atomic_load(p, __ATOMIC_RELAXED, __HIP_MEMORY_SCOPE_AGENT); }
DI unsigned xb_add(unsigned* p, unsigned v) { return __hip_atomic_fetch_add(p, v, __ATOMIC_RELAXED, __HIP_MEMORY_SCOPE_AGENT); }
DI unsigned xb_xcc_id() { return (unsigned)__builtin_amdgcn_s_getreg((3 << 11) | 20) & 0xFu; }
#define XB_SPIN(cond, bar) do { unsigned _sp = 0; while (cond) { __builtin_amdgcn_s_sleep(1); \
    if ((++_sp & 255u) == 0u) { if (xb_ld(&(bar)[XB_TMO])) break; if (_sp > XB_SPIN_CAP) { atomicAdd(&(bar)[XB_TMO], 1u); break; } } } } while (0)
struct XcdBarrier { unsigned* bar; unsigned x; };
DI XcdBarrier xcd_barrier_post(unsigned* bar) {
  XcdBarrier b; b.bar = bar; b.x = xb_xcc_id();
  if (threadIdx.x == 0) (void)xb_add(&bar[XB_XCNT(b.x)], 1u);
  return b;
}
DI void xcd_barrier_complete(unsigned* bar, unsigned x, unsigned& nloc, unsigned& nx) {
  const unsigned G = gridDim.x * gridDim.y * gridDim.z;
  unsigned sum, cnt, mine, sp = 0u;
  for (;;) {
    sum = 0u; cnt = 0u; mine = 0u;
#pragma unroll
    for (unsigned j = 0; j < 16; ++j) { const unsigned c = xb_ld(&bar[XB_XCNT(j)]); sum += c; cnt += (c > 0u) ? 1u : 0u; mine = (j == x) ? c : mine; }
    if (sum == G) break;
    __builtin_amdgcn_s_sleep(1);
    if ((++sp & 255u) == 0u) { if (xb_ld(&bar[XB_TMO])) break; if (sp > XB_SPIN_CAP) { atomicAdd(&bar[XB_TMO], 1u); break; } }
  }
  nloc = mine > 0u ? mine : 1u; nx = cnt > 0u ? cnt : 1u;
}
DI void xcd_barrier(const XcdBarrier& b, volatile unsigned* st) {
  asm volatile("s_waitcnt vmcnt(0)" ::: "memory");
  __syncthreads();
  if (threadIdx.x == 0) {
    unsigned* bar = b.bar;
    const unsigned bx = xb_xcc_id();
    __builtin_amdgcn_s_waitcnt(0);
    unsigned nloc = st[0], nx = st[1];
    if (nloc == 0u) { xcd_barrier_complete(bar, bx, nloc, nx); st[0] = nloc; st[1] = nx; }
    const unsigned old = xb_add(&bar[XB_XSUB(bx)], 1u);
    const unsigned gen = old / nloc;
    if (old + 1u == (gen + 1u) * nloc) {
      __builtin_amdgcn_fence(__ATOMIC_RELEASE, "agent");
      asm volatile("s_waitcnt vmcnt(0)" ::: "memory");
      const unsigned og = xb_add(&bar[XB_TOP], 1u);
      const unsigned tg = og / nx;
      if (og + 1u == (tg + 1u) * nx) xb_add(&bar[XB_TOPGEN], 1u);
      else XB_SPIN(xb_ld(&bar[XB_TOPGEN]) == tg, bar);
      __builtin_amdgcn_fence(__ATOMIC_ACQUIRE, "agent");
      xb_add(&bar[XB_XGEN(bx)], 1u);
      asm volatile("s_waitcnt vmcnt(0)" ::: "memory");
    } else {
      XB_SPIN(xb_ld(&bar[XB_XGEN(bx)]) == gen, bar);
      __builtin_amdgcn_fence(__ATOMIC_ACQUIRE, "agent");
      asm volatile("s_waitcnt vmcnt(0)" ::: "memory");
    }
  }
  __syncthreads();
}

DI void phase_ogla(const Params& p, char* lds, int l) {
  const int tid = opaque_tid(), lane = tid & 63, r = lane & 31, h = lane >> 5;
  const int wave = __builtin_amdgcn_readfirstlane(tid >> 6), hh = wave >> 1, tb = wave & 1;
  const bfu* qs = (const bfu*)(p.ws + WS_QS); const bfu* ub = (const bfu*)(p.ws + WS_U);
  const bfu* proj = (const bfu*)(p.ws + WS_PROJ); bfu* mix = (bfu*)(p.ws + WS_H);
  const float* gg = p.gla_g + l * 128;
  for (int it = blockIdx.x; it < BATCH * NCH; it += gridDim.x) {
    const int b = it >> 8, c = it & 255;
    const size_t row = (size_t)b * SEQ + c * 64 + tb * 32 + r;
    bf16x8 qf[4];
#pragma unroll
    for (int ks = 0; ks < 4; ++ks) qf[ks] = *(const bf16x8*)(qs + row * 256 + hh * 64 + ks * 16 + h * 8);
    const bfu* sp = ub + (size_t)((b * NCH + c) * 4 + hh) * 8192;
    f32x16 O[4];
#pragma unroll
    for (int d = 0; d < 4; ++d) {
#pragma unroll
      for (int e = 0; e < 16; ++e) O[d][e] = 0.f;
#pragma unroll
      for (int ks = 0; ks < 4; ++ks) {
        const bf16x8 sf = *(const bf16x8*)(sp + (d * 32 + r) * 64 + ks * 16 + h * 8);
        O[d] = MFMA32(sf, qf[ks], O[d]);
      }
    }
    float ss = 0.f;
#pragma unroll
    for (int d = 0; d < 4; ++d)
#pragma unroll
      for (int e = 0; e < 16; ++e) ss += O[d][e] * O[d][e];
    ss += __shfl_xor(ss, 32);
    const float rstd = rsqrtf(ss * (1.f / 128.f) + EPS);
    char* stg = lds + wave * 16896;
    asm volatile("s_waitcnt lgkmcnt(0)" ::: "memory");
#pragma unroll
    for (int d = 0; d < 4; ++d)
#pragma unroll
      for (int g = 0; g < 4; ++g) {
        float4 o; o.x = O[d][4 * g] * rstd; o.y = O[d][4 * g + 1] * rstd; o.z = O[d][4 * g + 2] * rstd; o.w = O[d][4 * g + 3] * rstd;
        *(float4*)(stg + r * 528 + (d * 32 + 8 * g + 4 * h) * 4) = o;
      }
    asm volatile("s_waitcnt lgkmcnt(0)" ::: "memory");
    const size_t row0 = (size_t)b * SEQ + c * 64 + tb * 32;
#pragma unroll
    for (int it2 = 0; it2 < 16; ++it2) {
      const int id = it2 * 64 + lane, rr = id >> 5, cc = id & 31;
      const float4 v = *(const float4*)(stg + rr * 528 + cc * 16);
      const uint2 zr = *(const uint2*)(proj + (row0 + rr) * NP + C_GZ + hh * 128 + cc * 4);
      const float4 gv = *(const float4*)(gg + cc * 4);
      const float z0 = bf2f(zr.x & 0xffffu), z1 = __uint_as_float(zr.x & 0xffff0000u), z2 = bf2f(zr.y & 0xffffu), z3 = __uint_as_float(zr.y & 0xffff0000u);
      uint2 o;
      o.x = cvtpk(v.x * gv.x * silu_f(z0), v.y * gv.y * silu_f(z1));
      o.y = cvtpk(v.z * gv.z * silu_f(z2), v.w * gv.w * silu_f(z3));
      *(uint2*)(mix + (row0 + rr) * 1024 + hh * 128 + cc * 4) = o;
    }
  }
}

DI void scan_items(const Params& p) {
  const int tid = opaque_tid();
  bfu* ub = (bfu*)(p.ws + WS_U); const float* ab = (const float*)(p.ws + WS_A);
  if (tid < 256) {
    for (int it = blockIdx.x; it < 256; it += gridDim.x) {
      const int e = it * 256 + tid, b = e >> 15, rem = e & 32767, hh = rem >> 13, dk = rem & 63;
      bfu* up = ub + (size_t)b * NCH * 32768 + rem;
      const float* ap = ab + (size_t)b * NCH * 256 + hh * 64 + dk;
      float st = 0.f;
      for (int c0 = 0; c0 < NCH; c0 += 32) {
        bfu uv[32]; float av[32];
#pragma unroll
        for (int i = 0; i < 32; ++i) { uv[i] = up[(size_t)(c0 + i) * 32768]; av[i] = ap[(c0 + i) * 256]; }
#pragma unroll
        for (int i = 0; i < 32; ++i) { st = av[i] * st + bf2f(uv[i]); up[(size_t)(c0 + i) * 32768] = f2bf(st); }
      }
    }
  }
}

DI void attn_item(const Params& p, char* lds, int l, int bh, int jt, float lam, float outscale) {
  const int tid = opaque_tid(), lane = tid & 63, r = lane & 31, h = lane >> 5;
  const int wave = __builtin_amdgcn_readfirstlane(tid >> 6);
  const bfu* Kg = (const bfu*)(p.ws + WS_KN) + (size_t)bh * SEQ * 128;
  const bfu* Qg = (const bfu*)(p.ws + WS_QN) + (size_t)bh * SEQ * 128;
  const bfu* Vg = (const bfu*)(p.ws + WS_VT) + (size_t)bh * 128 * SEQ;
  const int nkt = 4 * jt + 4, my_last = 4 * jt + (wave >> 1);
  const int qrow = jt * 256 + wave * 32 + r;
  const int krow_l = 4 * wave + (lane >> 4), kp = lane & 15;
  const bfu* kgp = Kg + (size_t)krow_l * 128 + ((kp ^ (krow_l & 15)) * 8);
  const int vrow_l = 8 * wave + (lane >> 3), vp = lane & 7;
  const bfu* vgp = Vg + (size_t)vrow_l * SEQ + ((vp ^ ((vrow_l >> 1) & 7)) * 8);
  const unsigned lds0 = (unsigned)(uintptr_t)lds;
  const unsigned dk0 = (unsigned)__builtin_amdgcn_readfirstlane(lds0 + wave * 1024);
#define DMA_TILE(kt_, so_) do { glds16(kgp + (size_t)(kt_) * 64 * 128, dk0 + (so_)); glds16(kgp + (size_t)(kt_) * 64 * 128 + 32 * 128, dk0 + (so_) + 8192); \
    glds16(vgp + (kt_) * 64, dk0 + (so_) + 16384); glds16(vgp + (size_t)64 * SEQ + (kt_) * 64, dk0 + (so_) + 24576); } while (0)
  WAIT_BAR0();
  DMA_TILE(0, 0);
  char* q1s = lds + 65536 + tid * 16;
#pragma unroll
  for (int ks = 0; ks < 4; ++ks) {
    *(bf16x8*)(q1s + 32768 + ks * 8192) = *(const bf16x8*)(Qg + (size_t)qrow * 128 + ks * 16 + h * 8);
    *(bf16x8*)(q1s + ks * 8192) = *(const bf16x8*)(Qg + (size_t)qrow * 128 + 64 + ks * 16 + h * 8);
  }
  f32x16 O0[4], O1[4];
#pragma unroll
  for (int d = 0; d < 4; ++d)
#pragma unroll
    for (int e = 0; e < 16; ++e) { O0[d][e] = 0.f; O1[d][e] = 0.f; }
  float l0 = 0.f, l1 = 0.f;
  const int pr = pi_row(r);
  const unsigned kb = pr * 256 + (((pr & 15) ^ h) << 4);
  const unsigned vb = 16384 + r * 128 + ((((r >> 1) & 7) ^ h) << 4);
  for (int kt = 0; kt < nkt; ++kt) {
    WAIT_BAR0();
    const unsigned so = (kt & 1) * 32768;
    if (kt + 1 < nkt) DMA_TILE(kt + 1, 32768 - so);
    if (kt <= my_last) {
#define KFRAG(sub_, mp_, ks_) (*(const bf16x8*)(lds + ((kb + so + (sub_) * 8192) ^ (unsigned)((((mp_) * 8) + (ks_) * 2) << 4))))
#define VFRAG(sub_, d_, s_) (*(const bf16x8*)(lds + ((vb + so + (d_) * 4096) ^ (unsigned)(((sub_) * 4 + (s_) * 2) << 4))))
#define QFRAG(mp_, ks_) (*(const bf16x8*)(q1s + ((mp_) ? 0 : 32768) + (ks_) * 8192))
#define SOFTMAX_PACK(S_, P_, l_) do { _Pragma("unroll") for (int e = 0; e < 16; ++e) { S_[e] = __builtin_amdgcn_exp2f(S_[e]); l_ += S_[e]; } \
        _Pragma("unroll") for (int s = 0; s < 2; ++s) { u32x4 a_; _Pragma("unroll") for (int q = 0; q < 4; ++q) a_[q] = cvtpk(S_[8 * s + 2 * q], S_[8 * s + 2 * q + 1]); P_[s] = __builtin_bit_cast(bf16x8, a_); } } while (0)
      bf16x8 pa0[2], pa1[2];
      f32x16 S0, S1;
#pragma unroll
      for (int e = 0; e < 16; ++e) { S0[e] = 0.f; S1[e] = 0.f; }
#pragma unroll
      for (int ks = 0; ks < 4; ++ks) {
        S0 = MFMA32(KFRAG(0, 0, ks), QFRAG(0, ks), S0);
        S1 = MFMA32(KFRAG(0, 1, ks), QFRAG(1, ks), S1);
      }
      SOFTMAX_PACK(S0, pa0, l0);
      SOFTMAX_PACK(S1, pa1, l1);
#pragma unroll
      for (int e = 0; e < 16; ++e) { S0[e] = 0.f; S1[e] = 0.f; }
#pragma unroll
      for (int ks = 0; ks < 4; ++ks) {
        S0 = MFMA32(KFRAG(1, 0, ks), QFRAG(0, ks), S0);
        S1 = MFMA32(KFRAG(1, 1, ks), QFRAG(1, ks), S1);
#pragma unroll
        for (int dd = 0; dd < 2; ++dd) {
          const int d = (ks & 1) * 2 + dd, s = ks >> 1;
          const bf16x8 vf = VFRAG(0, d, s);
          O0[d] = MFMA32(vf, pa0[s], O0[d]);
          O1[d] = MFMA32(vf, pa1[s], O1[d]);
        }
      }
      bf16x8 pc0[2], pc1[2];
      SOFTMAX_PACK(S0, pc0, l0);
      SOFTMAX_PACK(S1, pc1, l1);
#pragma unroll
      for (int s = 0; s < 2; ++s) {
#pragma unroll
        for (int d = 0; d < 4; ++d) {
          const bf16x8 vf = VFRAG(1, d, s);
          O0[d] = MFMA32(vf, pc0[s], O0[d]);
          O1[d] = MFMA32(vf, pc1[s], O1[d]);
        }
      }
#undef KFRAG
#undef VFRAG
#undef QFRAG
#undef SOFTMAX_PACK
    }
  }
#undef DMA_TILE
  l0 += __shfl_xor(l0, 32); l1 += __shfl_xor(l1, 32);
  const float i0 = 1.f / l0, i1 = -lam / l1;
  float ss = 0.f;
#pragma unroll
  for (int d = 0; d < 4; ++d)
#pragma unroll
    for (int e = 0; e < 16; ++e) { const float o = O0[d][e] * i0 + O1[d][e] * i1; O0[d][e] = o; ss += o * o; }
  ss += __shfl_xor(ss, 32);
  const float rstd = rsqrtf(ss * (1.f / 128.f) + EPS) * outscale;
  const int b = bh >> 2, hh = bh & 3;
  const size_t row = (size_t)b * SEQ + qrow;
  const bfu* zp = (const bfu*)(p.ws + WS_PROJ) + row * NP + C_DZ + hh * 128;
  bfu* mp = (bfu*)(p.ws + WS_H) + row * 1024 + 512 + hh * 128;
  const float* gd = p.diff_g + l * 128;
#pragma unroll
  for (int d = 0; d < 4; ++d)
#pragma unroll
    for (int g = 0; g < 4; ++g) {
      const int dv = d * 32 + 8 * g + 4 * h;
      const uint2 zr = *(const uint2*)(zp + dv);
      const float4 gv = *(const float4*)(gd + dv);
      const float z0 = bf2f(zr.x & 0xffffu), z1 = __uint_as_float(zr.x & 0xffff0000u), z2 = bf2f(zr.y & 0xffffu), z3 = __uint_as_float(zr.y & 0xffff0000u);
      uint2 o;
      o.x = cvtpk(O0[d][4 * g] * rstd * gv.x * silu_f(z0), O0[d][4 * g + 1] * rstd * gv.y * silu_f(z1));
      o.y = cvtpk(O0[d][4 * g + 2] * rstd * gv.z * silu_f(z2), O0[d][4 * g + 3] * rstd * gv.w * silu_f(z3));
      *(uint2*)(mp + dv) = o;
    }
}

DI void phase_attn(const Params& p, char* lds, int l) {
  scan_items(p);
  const float lam = ((const float*)(p.ws + WS_LAM))[l];
  const float outscale = 1.f - p.lam_init[l];
  unsigned* scnt = (unsigned*)(p.ws + WS_BAR) + 3584;
  asm volatile("s_waitcnt vmcnt(0)" ::: "memory");
  __syncthreads();
  if (threadIdx.x == 0) {
    __builtin_amdgcn_fence(__ATOMIC_RELEASE, "agent");
    asm volatile("s_waitcnt vmcnt(0)" ::: "memory");
    (void)xb_add(scnt, 1u);
  }
  if (__builtin_amdgcn_readfirstlane(threadIdx.x) >= 256) __builtin_amdgcn_s_setprio(1);
  for (int pr = blockIdx.x; pr < 256; pr += gridDim.x) {
    const int bh = pr & 7, jj = pr >> 3;
#pragma unroll 1
    for (int rep = 0; rep < 2; ++rep) attn_item(p, lds, l, bh, rep ? jj : 63 - jj, lam, outscale);
  }
  __builtin_amdgcn_s_setprio(0);
  if (threadIdx.x == 0) {
    const unsigned target = gridDim.x * (unsigned)(l + 1);
    unsigned sp = 0;
    while (xb_ld(scnt) < target) { __builtin_amdgcn_s_sleep(1); if (++sp > (1u << 22)) break; }
    __builtin_amdgcn_fence(__ATOMIC_ACQUIRE, "agent");
    asm volatile("s_waitcnt vmcnt(0)" ::: "memory");
  }
  __syncthreads();
  phase_ogla(p, lds, l);
}

__global__ void __launch_bounds__(NT) fwd_megakernel(Params p) {
  extern __shared__ __attribute__((aligned(16))) char lds[];
  cg::grid_group grid = cg::this_grid();
  volatile unsigned* xst = (volatile unsigned*)(lds + LDS_BYTES);
  if (threadIdx.x == 0) { xst[0] = 0u; xst[1] = 0u; }
  __syncthreads();
  const XcdBarrier xbar = xcd_barrier_post((unsigned*)(p.ws + WS_BAR));
#define GBAR() xcd_barrier(xbar, (volatile unsigned*)(lds + LDS_BYTES))
  p0_prologue(p, lds);
  grid.sync();
#pragma unroll 1
  for (int l = 0; l < DEPTH; ++l) {
    const float* xin = (l == 0) ? p.x : p.out;
    phase_norm(p, l, xin);
    GBAR();
    gemm_phase<0>(p, lds, (const bfu*)(p.ws + WS_H), (const bfu*)(p.ws + WS_WINT) + (size_t)l * NP * 1024, 14, l, nullptr);
    GBAR();
    phase_prep(p, lds, l);
    GBAR();
    phase_attn(p, lds, l);
    GBAR();
    gemm_phase<1>(p, lds, (const bfu*)(p.ws + WS_H), (const bfu*)(p.ws + WS_WOUTT) + (size_t)l * 1024 * 1024, 4, l, xin);
    if (l + 1 < DEPTH) GBAR();
  }
#undef GBAR
}

#ifndef MK_SPLIT
#define MK_SPLIT 0
#endif

extern "C" void kernel_launch(void* const* d_in, const int* in_sizes, int n_in, void* d_out, int out_size, void* d_ws, size_t ws_size, hipStream_t stream) {
  static int grid_blocks = 0;
  if (!grid_blocks) {
    if (ws_size < WS_END) { fprintf(stderr, "kernel_launch: workspace too small: %zu < %zu\n", ws_size, (size_t)WS_END); grid_blocks = -1; return; }
    int dev = 0, cus = 0, per_cu = 0;
    hipGetDevice(&dev);
    hipDeviceGetAttribute(&cus, hipDeviceAttributeMultiprocessorCount, dev);
    hipFuncSetAttribute((const void*)fwd_megakernel, hipFuncAttributeMaxDynamicSharedMemorySize, LDS_BYTES + 16);
    hipOccupancyMaxActiveBlocksPerMultiprocessor(&per_cu, (const void*)fwd_megakernel, NT, LDS_BYTES + 16);
    if (per_cu < 1) per_cu = 1;
    if (per_cu > 1) per_cu = 1;
    grid_blocks = cus * per_cu;
  }
  if (grid_blocks < 0) return;
  Params p{};
  p.x = (const float*)d_in[0]; p.c = (const float*)d_in[1]; p.w_ada = (const float*)d_in[2]; p.b_ada = (const float*)d_in[3];
  p.norm_g = (const float*)d_in[4]; p.w_in = (const float*)d_in[5]; p.conv_w = (const float*)d_in[6]; p.w_gk = (const float*)d_in[7];
  p.b_gk = (const float*)d_in[8]; p.gla_g = (const float*)d_in[9]; p.qn_g = (const float*)d_in[10]; p.kn_g = (const float*)d_in[11];
  p.lq1 = (const float*)d_in[12]; p.lk1 = (const float*)d_in[13]; p.lq2 = (const float*)d_in[14]; p.lk2 = (const float*)d_in[15];
  p.diff_g = (const float*)d_in[16]; p.w_out = (const float*)d_in[17];
  p.out = (float*)d_out; p.ws = (unsigned char*)d_ws;
  const double li[4] = {0.8 - 0.6 * 1.0, 0.8 - 0.6 * 0.7408182206817179, 0.8 - 0.6 * 0.5488116360940264, 0.8 - 0.6 * 0.4065696597405991};
  for (int l = 0; l < 4; ++l) p.lam_init[l] = (float)li[l];
  hipMemsetAsync((char*)d_ws + WS_BAR, 0, 16384, stream);
  constexpr int NPH = 2 + 6 * DEPTH;
  void* args[] = {&p};
  hipError_t e = hipLaunchCooperativeKernel((void*)fwd_megakernel, dim3(grid_blocks), dim3(NT), args, LDS_BYTES + 16, stream);
  if (e != hipSuccess) fprintf(stderr, "cooperative launch failed: %s (grid %d)\n", hipGetErrorString(e), grid_blocks);
}
```

```cpp
#include <hip/hip_runtime.h>
#include <hip/hip_bf16.h>
#include <hip/hip_cooperative_groups.h>
#include <cstdio>
#include <cstdint>
namespace cg = cooperative_groups;

#define DI __device__ __forceinline__
typedef unsigned short bfu;
using bf16x8 = __attribute__((ext_vector_type(8))) short;
using f32x16 = __attribute__((ext_vector_type(16))) float;
using u32x4  = __attribute__((ext_vector_type(4))) unsigned;
#define MFMA32(a, b, c) __builtin_amdgcn_mfma_f32_32x32x16_bf16((a), (b), (c), 0, 0, 0)

constexpr int D = 1024, BATCH = 2, SEQ = 16384, DEPTH = 4, T = BATCH * SEQ;
constexpr int NCH = SEQ / 64;
constexpr int INW = 3600, NP = 3840;
constexpr int C_GQ = 0, C_GK = 256, C_GV = 512, C_GZ = 1024, C_DQ = 1536, C_DK = 2048, C_DV = 2560, C_DZ = 3072, C_GLR = 3584;
constexpr float EPS = 1e-6f;
constexpr float LOG2E = 1.4426950408889634f;
constexpr int NT = 512;
constexpr int LDS_BYTES = 139264;

constexpr size_t WS_WINT = 0;
constexpr size_t WS_WOUTT = WS_WINT + (size_t)DEPTH * NP * D * 2;
constexpr size_t WS_MODP = WS_WOUTT + (size_t)DEPTH * D * D * 2;
constexpr size_t WS_MOD = WS_MODP + (size_t)DEPTH * 8 * 2 * 3072 * 4;
constexpr size_t WS_LAM = WS_MOD + (size_t)DEPTH * 2 * 3072 * 4;
constexpr size_t WS_H = WS_LAM + 256;
constexpr size_t WS_PROJ = WS_H + (size_t)T * D * 2;
constexpr size_t WS_U = WS_PROJ + (size_t)T * NP * 2;
constexpr size_t WS_A = WS_U + (size_t)BATCH * NCH * 4 * 8192 * 2;
constexpr size_t WS_QS = WS_A + (size_t)BATCH * NCH * 256 * 4;
constexpr size_t WS_QN = WS_QS + (size_t)T * 256 * 2;
constexpr size_t WS_KN = WS_QN + (size_t)T * 512 * 2;
constexpr size_t WS_VT = WS_KN + (size_t)T * 512 * 2;
constexpr size_t WS_BAR = WS_VT + (size_t)T * 512 * 2;
constexpr size_t WS_END = WS_BAR + 16384;

struct Params {
  const float *x, *c, *w_ada, *b_ada, *norm_g, *w_in, *conv_w, *w_gk, *b_gk, *gla_g, *qn_g, *kn_g, *lq1, *lk1, *lq2, *lk2, *diff_g, *w_out;
  float* out; unsigned char* ws;
  float lam_init[4];
  int ph_lo, ph_hi;
};

DI int opaque_tid() { int t = threadIdx.x; asm volatile("" : "+v"(t)); return t; }
DI float bf2f(unsigned u) { return __uint_as_float(u << 16); }
typedef __bf16 bf16x2_t __attribute__((ext_vector_type(2)));
typedef float f32x2_t __attribute__((ext_vector_type(2)));
DI unsigned cvtpk(float lo, float hi) { f32x2_t v = {lo, hi}; bf16x2_t r = __builtin_convertvector(v, bf16x2_t); return __builtin_bit_cast(unsigned, r); }
DI bfu f2bf(float x) { return (bfu)(cvtpk(x, 0.f) & 0xffffu); }
DI float silu_f(float x) { return x * __builtin_amdgcn_rcpf(1.f + __expf(-x)); }
DI int crow(int reg, int h) { return (reg & 3) + 8 * (reg >> 2) + 4 * h; }
DI int pi_row(int r) { return (r & ~12) | ((r & 4) << 1) | ((r & 8) >> 1); }
DI float wave_sum(float v) {
#pragma unroll
  for (int o = 32; o >= 1; o >>= 1) v += __shfl_xor(v, o);
  return v;
}

DI void glds16(const void* g, unsigned lds_base) {
  unsigned sv; asm volatile("s_mov_b32 %0, m0\n\ts_mov_b32 m0, %2\n\ts_nop 0\n\tglobal_load_lds_dwordx4 %1, off\n\ts_mov_b32 m0, %0" : "=&s"(sv) : "v"(g), "s"(lds_base) : "memory"); }
#define WAIT_BAR0() asm volatile("s_waitcnt vmcnt(0) lgkmcnt(0)\n\ts_barrier" ::: "memory")


DI void p0_prologue(const Params& p, char* lds) {
  const int tid = opaque_tid(), lane = tid & 63;
  const int wave = __builtin_amdgcn_readfirstlane(tid >> 6);
  bfu* WinT = (bfu*)(p.ws + WS_WINT); bfu* WoutT = (bfu*)(p.ws + WS_WOUTT);
  float* lamv = (float*)(p.ws + WS_LAM);
  constexpr int N_MOD = DEPTH * 48;
  {
    float* red = (float*)lds;
    for (int it = blockIdx.x; it < N_MOD + 1; it += gridDim.x) {
      if (it < N_MOD) {
        const int l = it / 48, jb = it % 48;
        const int j = lane, ks = wave;
        float a0 = 0.f, a1 = 0.f;
        const float* wp = p.w_ada + (size_t)(l * 1024 + ks * 128) * 3072 + jb * 64 + j;
        const float* cp = p.c + ks * 128;
#pragma unroll 32
        for (int k = 0; k < 128; ++k) { const float w = wp[(size_t)k * 3072]; a0 += silu_f(cp[k]) * w; a1 += silu_f(cp[1024 + k]) * w; }
        red[(ks * 2 + 0) * 64 + j] = a0; red[(ks * 2 + 1) * 64 + j] = a1;
        __syncthreads();
        if (tid < 128) {
          const int b = tid >> 6;
          float acc = p.b_ada[l * 3072 + jb * 64 + j];
#pragma unroll
          for (int q = 0; q < 8; ++q) acc += red[(q * 2 + b) * 64 + j];
          ((float*)(p.ws + WS_MOD))[(l * 2 + b) * 3072 + jb * 64 + j] = acc;
        }
        __syncthreads();
      } else if (tid < 64) {
        for (int l = 0; l < DEPTH; ++l) {
          float s1 = p.lq1[l * 64 + tid] * p.lk1[l * 64 + tid], s2 = p.lq2[l * 64 + tid] * p.lk2[l * 64 + tid];
          s1 = wave_sum(s1); s2 = wave_sum(s2);
          if (tid == 0) lamv[l] = expf(s1) - expf(s2) + p.lam_init[l];
        }
      }
    }
  }
}

DI void p0_tiles(const Params& p, char* lds) {
  const int tid = opaque_tid(), lane = tid & 63;
  const int wave = __builtin_amdgcn_readfirstlane(tid >> 6);
  bfu* WinT = (bfu*)(p.ws + WS_WINT); bfu* WoutT = (bfu*)(p.ws + WS_WOUTT);
  {
    constexpr int N_IN = DEPTH * 16 * 57, N_OUT = DEPTH * 16 * 16;
    float* tile = (float*)(lds + wave * 16640);
    for (int it = blockIdx.x * 8 + wave; it < N_IN + N_OUT; it += gridDim.x * 8) {
      const bool isin = it < N_IN;
      int l, kt, nt;
      if (isin) { l = it / (16 * 57); int rr = it % (16 * 57); nt = rr / 16; kt = rr % 16; }
      else { int r2 = it - N_IN; l = r2 / 256; int rr = r2 % 256; nt = rr / 16; kt = rr % 16; }
      const int k0 = kt * 64, n0 = nt * 64;
      const int np = n0 + lane;
      const int on = np < 1024 ? np : (np < 3584 ? np + 16 : (np < 3600 ? np - 3584 + 1024 : -1));
      const float* srcp = isin ? (p.w_in + (size_t)(l * 1024 + k0) * INW + (on >= 0 ? on : 0)) : (p.w_out + (size_t)(l * 1024 + k0) * 1024 + n0 + lane);
      const size_t pitch = isin ? INW : 1024;
      const bool live = !isin || on >= 0;
      float v[64];
#pragma unroll
      for (int kk = 0; kk < 64; ++kk) v[kk] = live ? srcp[(size_t)kk * pitch] : 0.f;
      asm volatile("s_waitcnt lgkmcnt(0)" ::: "memory");
#pragma unroll
      for (int kk = 0; kk < 64; ++kk) tile[kk * 65 + lane] = v[kk];
      asm volatile("s_waitcnt lgkmcnt(0)" ::: "memory");
#pragma unroll
      for (int q = 0; q < 8; ++q) {
        const int nn = q * 8 + (lane >> 3), kc = lane & 7;
        const float* tp = tile + (kc * 8) * 65 + nn;
        uint4 o; o.x = cvtpk(tp[0], tp[65]); o.y = cvtpk(tp[130], tp[195]); o.z = cvtpk(tp[260], tp[325]); o.w = cvtpk(tp[390], tp[455]);
        bfu* dst = isin ? (WinT + ((size_t)l * NP + n0 + nn) * 1024 + k0 + kc * 8) : (WoutT + ((size_t)l * 1024 + n0 + nn) * 1024 + k0 + kc * 8);
        *(uint4*)dst = o;
      }
    }
  }
}

DI void phase_norm(const Params& p, int l, const float* xin) {
  const int tid = opaque_tid(), lane = tid & 63, wave = tid >> 6;
  const float* g = p.norm_g + l * 1024; const float* md = (const float*)(p.ws + WS_MOD) + l * 6144;
  bfu* hb = (bfu*)(p.ws + WS_H);
  for (int r0 = (blockIdx.x * 8 + wave) * 16; r0 < T; r0 += gridDim.x * 8 * 16) {
    const int b = r0 >> 14;
    float4 ga[4], sh[4];
#pragma unroll
    for (int i = 0; i < 4; ++i) {
      const int k = (lane + 64 * i) * 4;
      const float4 g4 = *(const float4*)(g + k), sc = *(const float4*)(md + b * 3072 + 1024 + k);
      sh[i] = *(const float4*)(md + b * 3072 + k);
      ga[i].x = g4.x * (1.f + sc.x); ga[i].y = g4.y * (1.f + sc.y); ga[i].z = g4.z * (1.f + sc.z); ga[i].w = g4.w * (1.f + sc.w);
    }
#pragma unroll 1
    for (int rg = 0; rg < 16; rg += 4) {
      float4 v[4][4];
#pragma unroll
      for (int q = 0; q < 4; ++q) {
        const float4* xr = (const float4*)(xin + (size_t)(r0 + rg + q) * 1024);
#pragma unroll
        for (int i = 0; i < 4; ++i) v[q][i] = xr[lane + 64 * i];
      }
#pragma unroll
      for (int q = 0; q < 4; ++q) {
        float ss = 0.f;
#pragma unroll
        for (int i = 0; i < 4; ++i) ss += v[q][i].x * v[q][i].x + v[q][i].y * v[q][i].y + v[q][i].z * v[q][i].z + v[q][i].w * v[q][i].w;
        ss = wave_sum(ss);
        const float rstd = rsqrtf(ss * (1.f / 1024.f) + EPS);
#pragma unroll
        for (int i = 0; i < 4; ++i) {
          const int k = (lane + 64 * i) * 4;
          const float o0 = v[q][i].x * rstd * ga[i].x + sh[i].x, o1 = v[q][i].y * rstd * ga[i].y + sh[i].y;
          const float o2 = v[q][i].z * rstd * ga[i].z + sh[i].z, o3 = v[q][i].w * rstd * ga[i].w + sh[i].w;
          uint2 o; o.x = cvtpk(o0, o1); o.y = cvtpk(o2, o3);
          *(uint2*)(hb + (size_t)(r0 + rg + q) * 1024 + k) = o;
        }
      }
    }
  }
}

DI void tile_map(int idx, int ntn, int& tm, int& tn) {
  const int xcd = idx & 7, li = idx >> 3, g4 = 4 * ntn, g = li / g4, rem = li - g * g4;
  tn = rem >> 2; tm = xcd * 16 + g * 4 + (rem & 3);
}
template <int EPI>
DI void gemm_phase(const Params& p, char* lds, const bfu* __restrict__ A, const bfu* __restrict__ BT, int ntn, int l, const float* xin) {
  const int tid = opaque_tid(), lane = tid & 63, r = lane & 31, h = lane >> 5;
  const int wave = __builtin_amdgcn_readfirstlane(tid >> 6), wm = wave >> 1, wn = wave & 1;
  const int drow = 8 * wave + (lane >> 3);
  const int dsrc = drow * 1024 + (((lane & 7) ^ ((drow >> 1) & 7)) << 3);
  const unsigned lds0 = (unsigned)(uintptr_t)lds;
  const unsigned dd0 = (unsigned)__builtin_amdgcn_readfirstlane(lds0 + wave * 1024);
  const int swz = (r >> 1) & 7;
  const int ntiles = (T / 256) * ntn;
#define DMA_SLAB(Ap, Bp, kk, so) do { const bfu* a_ = (Ap) + dsrc + (kk) * 64; const bfu* b_ = (Bp) + dsrc + (kk) * 64; \
      _Pragma("unroll") for (int q_ = 0; q_ < 4; ++q_) { glds16(a_ + q_ * 64 * 1024, dd0 + (so) + q_ * 8192); glds16(b_ + q_ * 64 * 1024, dd0 + (so) + 32768 + q_ * 8192); } } while (0)
#define SBAR() __builtin_amdgcn_sched_barrier(0)
#define WSYNC() asm volatile("s_waitcnt lgkmcnt(0)" ::: "memory")
#define DMA_PIECE(Ap, Bp, kk, so, pz) glds16((((pz) < 4) ? (Ap) : (Bp)) + dsrc + (kk) * 64 + ((pz) & 3) * 64 * 1024, dd0 + (so) + ((pz) < 4 ? 0 : 32768) + ((pz) & 3) * 8192)
  WAIT_BAR0();
  if ((int)blockIdx.x < ntiles) {
    int tm, tn; tile_map((int)blockIdx.x, ntn, tm, tn);
    DMA_SLAB(A + (size_t)tm * 256 * 1024, BT + (size_t)tn * 256 * 1024, 0, 0);
  }
  WAIT_BAR0();
  for (int tile = blockIdx.x; tile < ntiles; tile += gridDim.x) {
    int tm, tn; tile_map(tile, ntn, tm, tn);
    const int m0 = tm * 256, n0 = tn * 256;
    const int cls = (EPI == 0) ? ((tn >= 6 && tn < 8) ? 1 : (tn >= 8 && tn < 10) ? 2 : (tn >= 10 && tn < 12) ? 3 : 0) : 0;
    const bool vtm = cls == 3;
    const int wA = vtm ? (wave & 1) : wm, wB = vtm ? (wave >> 1) : wn;
    const bfu* Ag = A + (size_t)m0 * 1024;
    const bfu* Bg = BT + (size_t)n0 * 1024;
    f32x16 acc[2][4];
#pragma unroll
    for (int i = 0; i < 2; ++i)
#pragma unroll
      for (int j = 0; j < 4; ++j)
#pragma unroll
        for (int e = 0; e < 16; ++e) acc[i][j][e] = 0.f;
    const bfu* An = Ag; const bfu* Bn = Bg;
    {
      const int nt_ = tile + gridDim.x;
      if (nt_ < ntiles) { int tm2, tn2; tile_map(nt_, ntn, tm2, tn2); An = A + (size_t)tm2 * 256 * 1024; Bn = BT + (size_t)tn2 * 256 * 1024; }
    }
    for (int kt = 0; kt < 16; ++kt) {
      if (kt == 0) asm volatile("s_waitcnt lgkmcnt(0)\n\ts_barrier" ::: "memory"); else WAIT_BAR0();
      const unsigned so = (kt & 1) * 65536;
      const bool dnext = (kt + 1 < 16) || (tile + (int)gridDim.x < ntiles);
      const bfu* dA = (kt + 1 < 16) ? Ag : An; const bfu* dB = (kt + 1 < 16) ? Bg : Bn;
      const int dk = (kt + 1 < 16) ? kt + 1 : 0; const unsigned dso = (kt + 1 < 16) ? 65536 - so : 0;
      const char* sb = lds + so;
      const char* pa = sb + (vtm ? 32768 + (wB * 64 + r) * 128 : (wA * 64 + r) * 128);
      const char* pb = sb + (vtm ? (wA * 128 + r) * 128 : 32768 + (wB * 128 + r) * 128);
      bf16x8 af[2][2], bfr[2][4];
      {
        const unsigned co = (unsigned)((h ^ swz) << 4);
        af[0][0] = *(const bf16x8*)(pa + co); af[0][1] = *(const bf16x8*)(pa + 4096 + co);
#pragma unroll
        for (int j = 0; j < 4; ++j) bfr[0][j] = *(const bf16x8*)(pb + j * 4096 + co);
      }
#pragma unroll
      for (int s = 0; s < 4; ++s) {
        if (s < 3) {
          const unsigned co = (unsigned)((((s + 1) * 2 + h) ^ swz) << 4);
          af[(s + 1) & 1][0] = *(const bf16x8*)(pa + co); af[(s + 1) & 1][1] = *(const bf16x8*)(pa + 4096 + co);
#pragma unroll
          for (int j = 0; j < 4; ++j) bfr[(s + 1) & 1][j] = *(const bf16x8*)(pb + j * 4096 + co);
        }
        SBAR();
#pragma unroll
        for (int i = 0; i < 2; ++i)
#pragma unroll
          for (int j = 0; j < 4; ++j) {
            acc[i][j] = MFMA32(bfr[s & 1][j], af[s & 1][i], acc[i][j]);
            if (s < 2 && (j & 1) && dnext) DMA_PIECE(dA, dB, dk, dso, s * 4 + i * 2 + (j >> 1));
          }
        SBAR();
      }
    }
    WAIT_BAR0();
    if (EPI == 0) {
      char* stg = lds + 65536 + wave * 9216;
#pragma unroll
      for (int jp = 0; jp < 2; ++jp) {
        if (cls == 1 || cls == 2) {
          const float* gg = (cls == 1 ? p.qn_g : p.kn_g) + l * 64;
          const float post = (cls == 1) ? 0.125f * LOG2E : 1.f;
#pragma unroll
          for (int i = 0; i < 2; ++i) {
            float ss = 0.f;
#pragma unroll
            for (int j2 = 0; j2 < 2; ++j2)
#pragma unroll
              for (int e = 0; e < 16; ++e) ss += acc[i][2 * jp + j2][e] * acc[i][2 * jp + j2][e];
            ss += __shfl_xor(ss, 32);
            const float rs = rsqrtf(ss * (1.f / 64.f) + EPS) * post;
#pragma unroll
            for (int j2 = 0; j2 < 2; ++j2)
#pragma unroll
              for (int g = 0; g < 4; ++g) {
                const float4 gv = *(const float4*)(gg + j2 * 32 + 8 * g + 4 * h);
                f32x16& a = acc[i][2 * jp + j2];
                a[4 * g] *= rs * gv.x; a[4 * g + 1] *= rs * gv.y; a[4 * g + 2] *= rs * gv.z; a[4 * g + 3] *= rs * gv.w;
              }
          }
        }
        if (jp) WSYNC();
#pragma unroll
        for (int i = 0; i < 2; ++i)
#pragma unroll
          for (int j2 = 0; j2 < 2; ++j2)
#pragma unroll
            for (int g = 0; g < 4; ++g) {
              const f32x16& a = acc[i][2 * jp + j2];
              uint2 o; o.x = cvtpk(a[4 * g], a[4 * g + 1]); o.y = cvtpk(a[4 * g + 2], a[4 * g + 3]);
              *(uint2*)(stg + (i * 32 + r) * 144 + (j2 * 32 + 8 * g + 4 * h) * 2) = o;
            }
        WSYNC();
        const int nc0 = n0 + wn * 128 + jp * 64;
        bfu* dst; size_t pitch;
        if (cls == 0) { dst = (bfu*)(p.ws + WS_PROJ) + (size_t)(m0 + wm * 64) * NP + nc0; pitch = NP; }
        else if (cls == 3) {
          const int col0 = n0 + wB * 64 - C_DV, bh = (m0 >> 14) * 4 + (col0 >> 7);
          dst = (bfu*)(p.ws + WS_VT) + ((size_t)bh * 128 + (col0 & 127)) * SEQ + ((m0 + wA * 128 + jp * 64) & (SEQ - 1)); pitch = SEQ;
        } else {
          const int col0 = nc0 - (cls == 1 ? C_DQ : C_DK), bh = (m0 >> 14) * 4 + (col0 >> 7);
          dst = (bfu*)(p.ws + (cls == 1 ? WS_QN : WS_KN)) + ((size_t)bh * SEQ + ((m0 + wm * 64) & (SEQ - 1))) * 128 + ((col0 >> 6) & 1) * 64; pitch = 128;
        }
#pragma unroll
        for (int it = 0; it < 8; ++it) {
          const int id = it * 64 + lane, row = id >> 3, c = id & 7;
          const uint4 v = *(const uint4*)(stg + row * 144 + c * 16);
          *(uint4*)(dst + (size_t)row * pitch + c * 8) = v;
        }
      }
    } else {
      char* stg = lds + 65536 + wave * 8704;
      const float* gate = (const float*)(p.ws + WS_MOD) + l * 6144 + (m0 >> 14) * 3072 + 2048;
      float4 xn[8];
#define LOADX(ps_) do { _Pragma("unroll") for (int it = 0; it < 8; ++it) { const int id = it * 64 + lane, row = id >> 4, c = id & 15; \
          xn[it] = *(const float4*)(xin + (size_t)(m0 + wm * 64 + ((ps_) >> 1) * 32 + row) * 1024 + n0 + wn * 128 + ((ps_) & 1) * 64 + c * 4); } } while (0)
      LOADX(0);
#pragma unroll
      for (int ps = 0; ps < 4; ++ps) {
        const int i = ps >> 1, jp = ps & 1;
        float4 xc[8];
#pragma unroll
        for (int it = 0; it < 8; ++it) xc[it] = xn[it];
        if (ps + 1 < 4) LOADX(ps + 1);
        if (ps) WSYNC();
#pragma unroll
        for (int j2 = 0; j2 < 2; ++j2)
#pragma unroll
          for (int g = 0; g < 4; ++g) {
            const f32x16& a = acc[i][2 * jp + j2];
            float4 o; o.x = a[4 * g]; o.y = a[4 * g + 1]; o.z = a[4 * g + 2]; o.w = a[4 * g + 3];
            *(float4*)(stg + r * 272 + (j2 * 32 + 8 * g + 4 * h) * 4) = o;
          }
        WSYNC();
#pragma unroll
        for (int it = 0; it < 8; ++it) {
          const int id = it * 64 + lane, row = id >> 4, c = id & 15;
          const float4 y = *(const float4*)(stg + row * 272 + c * 16);
          const int m = m0 + wm * 64 + i * 32 + row, n = n0 + wn * 128 + jp * 64 + c * 4;
          const float4 xv = xc[it];
          const float4 gv = *(const float4*)(gate + n);
          float4 o; o.x = xv.x + gv.x * y.x; o.y = xv.y + gv.y * y.y; o.z = xv.z + gv.z * y.z; o.w = xv.w + gv.w * y.w;
          *(float4*)(p.out + (size_t)m * 1024 + n) = o;
        }
      }
#undef LOADX
    }
  }
#undef DMA_SLAB
#undef DMA_PIECE
#undef SBAR
#undef WSYNC
  if (EPI == 0) {
    using f32x4 = __attribute__((ext_vector_type(4))) float;
    bfu* proj = (bfu*)(p.ws + WS_PROJ);
    const int quad = lane >> 4, c16 = lane & 15;
    const bfu* wrow = BT + (size_t)(C_GLR + c16) * 1024 + quad * 8;
    for (int rb = blockIdx.x * 8 + wave; rb < T / 16; rb += gridDim.x * 8) {
      const bfu* hrow = A + (size_t)(rb * 16 + c16) * 1024 + quad * 8;
      f32x4 c4 = {0.f, 0.f, 0.f, 0.f};
#pragma unroll 8
      for (int ks = 0; ks < 32; ++ks) {
        const bf16x8 wf = *(const bf16x8*)(wrow + ks * 32);
        const bf16x8 hf = *(const bf16x8*)(hrow + ks * 32);
        c4 = __builtin_amdgcn_mfma_f32_16x16x32_bf16(wf, hf, c4, 0, 0, 0);
      }
      uint2 o; o.x = cvtpk(c4[0], c4[1]); o.y = cvtpk(c4[2], c4[3]);
      *(uint2*)(proj + (size_t)(rb * 16 + c16) * NP + C_GLR + quad * 4) = o;
    }
  }
}

DI void prep_gla_load(const Params& p, int b, int c, int hh, uint4& v0, uint4& v1, uint4& v2, uint4& v3, uint4& v4) {
  const int tid = opaque_tid();
  const bfu* proj = (const bfu*)(p.ws + WS_PROJ);
  const int row0 = b * SEQ + c * 64;
#define PGL(i, vi) do { const int id = (i) * NT + tid; vi = make_uint4(0u, 0u, 0u, 0u); \
    if (id < 2144) { const int row = id >> 5, ch = id & 31; \
      const int col = ch < 8 ? (C_GQ + hh * 64 + ch * 8) : (ch < 16 ? (C_GK + hh * 64 + (ch - 8) * 8) : (C_GV + hh * 128 + (ch - 16) * 8)); \
      if (c > 0 || row >= 3) vi = *(const uint4*)(proj + (size_t)(row0 + row - 3) * NP + col); } \
    else if (id < 2272) { const int id2 = id - 2144; vi = *(const uint4*)(proj + (size_t)(row0 + (id2 >> 1)) * NP + C_GLR + (id2 & 1) * 8); } } while (0)
  PGL(0, v0); PGL(1, v1); PGL(2, v2); PGL(3, v3); PGL(4, v4);
#undef PGL
}
DI void prep_gla_item(const Params& p, char* lds, int l, int b, int c, int hh, const uint4& v0, const uint4& v1, const uint4& v2, const uint4& v3, const uint4& v4, int nb, int nc, int nh, bool has_next,
                      uint4& n0, uint4& n1, uint4& n2, uint4& n3, uint4& n4) {
  const int tid = opaque_tid(), lane = tid & 63, r = lane & 31, h = lane >> 5;
  const int wave = __builtin_amdgcn_readfirstlane(tid >> 6);
  char* X = lds;
  char* G = lds + 35376;
  float* kf = (float*)(lds + 37424);
  char* vT = lds + 54832;
  char* kdT = lds + 71216;
  float* tot = (float*)(lds + 79408);
  char* Qs = lds + 81456;
  const bfu* proj = (const bfu*)(p.ws + WS_PROJ);
  bfu* qs = (bfu*)(p.ws + WS_QS); bfu* ub = (bfu*)(p.ws + WS_U); float* ab = (float*)(p.ws + WS_A);
  const int row0 = b * SEQ + c * 64;
  {
#define PGS(i, vi) do { const int id = (i) * NT + tid; if (id < 2144) *(uint4*)(X + (id >> 5) * 528 + (id & 31) * 16) = vi; else if (id < 2272) *(uint4*)(G + (id - 2144) * 16) = vi; } while (0)
    PGS(0, v0); PGS(1, v1); PGS(2, v2); PGS(3, v3); PGS(4, v4);
#undef PGS
  }
  if (has_next) prep_gla_load(p, nb, nc, nh, n0, n1, n2, n3, n4);
  __syncthreads();
  {
    const int j = tid & 255, half = tid >> 8;
    const int col = j < 64 ? (C_GQ + hh * 64 + j) : (j < 128 ? (C_GK + hh * 64 + (j - 64)) : (C_GV + hh * 128 + (j - 128)));
    const float* cw = p.conv_w + (size_t)l * 4 * 1024 + col;
    const float w0 = cw[0], w1 = cw[1024], w2 = cw[2048], w3 = cw[3072];
    const int t0 = half * 32;
    const char* xs = X + t0 * 528 + j * 2;
    float x0 = bf2f(*(const bfu*)(xs)), x1 = bf2f(*(const bfu*)(xs + 528)), x2 = bf2f(*(const bfu*)(xs + 1056));
    float y[32];
#pragma unroll
    for (int tt = 0; tt < 32; ++tt) {
      const float xt = bf2f(*(const bfu*)(xs + (tt + 3) * 528));
      y[tt] = silu_f(w0 * x0 + w1 * x1 + w2 * x2 + w3 * xt);
      x0 = x1; x1 = x2; x2 = xt;
    }
    const int role = __builtin_amdgcn_readfirstlane(j >> 6);
    if (role == 0) {
#pragma unroll
      for (int tt = 0; tt < 32; ++tt) *(bfu*)(Qs + (t0 + tt) * 128 + j * 2) = f2bf(y[tt] * 0.125f);
    } else if (role == 1) {
      float* kr = kf + (j - 64) * 68 + t0;
#pragma unroll
      for (int q4 = 0; q4 < 8; ++q4) { float4 o; o.x = y[4 * q4]; o.y = y[4 * q4 + 1]; o.z = y[4 * q4 + 2]; o.w = y[4 * q4 + 3]; *(float4*)(kr + 4 * q4) = o; }
    } else {
      const int dv = j - 128;
#pragma unroll
      for (int cc = 0; cc < 4; ++cc) {
        uint4 o; o.x = cvtpk(y[8 * cc], y[8 * cc + 1]); o.y = cvtpk(y[8 * cc + 2], y[8 * cc + 3]); o.z = cvtpk(y[8 * cc + 4], y[8 * cc + 5]); o.w = cvtpk(y[8 * cc + 6], y[8 * cc + 7]);
        *(uint4*)(vT + dv * 128 + ((((t0 >> 3) + cc) ^ ((dv >> 1) & 7)) << 4)) = o;
      }
    }
  }
  __syncthreads();
  {
    const int dk = tid & 63, tg = wave;
    float wg[16];
#pragma unroll
    for (int q = 0; q < 16; ++q) wg[q] = p.w_gk[(size_t)(l * 16 + q) * 256 + hh * 64 + dk];
    const float bias = p.b_gk[l * 256 + hh * 64 + dk];
    float cs[8]; float cum = 0.f;
#pragma unroll
    for (int i = 0; i < 8; ++i) {
      const int t = tg * 8 + i;
      const uint4* gp = (const uint4*)(G + t * 32);
      const uint4 g0 = gp[0], g1 = gp[1];
      const unsigned gw[8] = {g0.x, g0.y, g0.z, g0.w, g1.x, g1.y, g1.z, g1.w};
      float z = bias;
#pragma unroll
      for (int q = 0; q < 8; ++q) { z += bf2f(gw[q] & 0xffffu) * wg[2 * q]; z += __uint_as_float(gw[q] & 0xffff0000u) * wg[2 * q + 1]; }
      const float ls = fminf(z, 0.f) - __logf(1.f + __expf(-fabsf(z)));
      cum += ls * (1.f / 16.f);
      cs[i] = cum;
    }
    tot[tg * 64 + dk] = cum;
    __syncthreads();
    float off = 0.f, total = 0.f;
#pragma unroll
    for (int g = 0; g < 8; ++g) { const float tv = tot[g * 64 + dk]; total += tv; if (g < tg) off += tv; }
    float kd[8];
    {
      const float4 ka = *(const float4*)(kf + dk * 68 + tg * 8), kb2 = *(const float4*)(kf + dk * 68 + tg * 8 + 4);
      const float kv[8] = {ka.x, ka.y, ka.z, ka.w, kb2.x, kb2.y, kb2.z, kb2.w};
#pragma unroll
      for (int i = 0; i < 8; ++i) kd[i] = kv[i] * __expf(total - (off + cs[i]));
    }
    {
      const int t = tid >> 3, c = tid & 7;
      *(uint4*)(qs + (size_t)(row0 + t) * 256 + hh * 64 + c * 8) = *(const uint4*)(Qs + t * 128 + c * 16);
    }
    uint4 o; o.x = cvtpk(kd[0], kd[1]); o.y = cvtpk(kd[2], kd[3]); o.z = cvtpk(kd[4], kd[5]); o.w = cvtpk(kd[6], kd[7]);
    *(uint4*)(kdT + dk * 128 + ((tg ^ ((dk >> 1) & 7)) << 4)) = o;
    if (tg == 0) ab[(size_t)(b * NCH + c) * 256 + hh * 64 + dk] = __expf(total);
  }
  __syncthreads();
  {
    const int dvb = wave >> 1, dkb = wave & 1;
    f32x16 acc;
#pragma unroll
    for (int e = 0; e < 16; ++e) acc[e] = 0.f;
    const int swz = (r >> 1) & 7;
#pragma unroll
    for (int s = 0; s < 4; ++s) {
      const unsigned co = (unsigned)(((s * 2 + h) ^ swz) << 4);
      const bf16x8 a = *(const bf16x8*)(vT + (dvb * 32 + r) * 128 + co);
      const bf16x8 bb = *(const bf16x8*)(kdT + (dkb * 32 + r) * 128 + co);
      acc = MFMA32(a, bb, acc);
    }
    bfu* up = ub + (size_t)((b * NCH + c) * 4 + hh) * 8192 + dkb * 32 + r;
#pragma unroll
    for (int e = 0; e < 16; ++e) up[(dvb * 32 + crow(e, h)) * 64] = f2bf(acc[e]);
  }
  __syncthreads();
}

DI void phase_prep(const Params& p, char* lds, int l) {
  constexpr int NIT = BATCH * NCH * 4;
  uint4 a0, a1, a2, a3, a4, b0, b1, b2, b3, b4;
  int it = blockIdx.x;
  if (it < NIT) prep_gla_load(p, (it & 511) >> 8, it & 255, it >> 9, a0, a1, a2, a3, a4);
  for (; it < NIT; it += gridDim.x) {
    const int ty = it >> 9, ch = it & 511, b = ch >> 8, c = ch & 255;
    const int nx = it + gridDim.x; const bool hn = nx < NIT;
    prep_gla_item(p, lds, l, b, c, ty, a0, a1, a2, a3, a4, (nx & 511) >> 8, nx & 255, nx >> 9, hn, b0, b1, b2, b3, b4);
    a0 = b0; a1 = b1; a2 = b2; a3 = b3; a4 = b4;
  }
}

#define XB_TMO      128
#define XB_XCNT(j)  (256  + 64 * (j))
#define XB_XSUB(j)  (1280 + 64 * (j))
#define XB_XGEN(j)  (2304 + 64 * (j))
#define XB_TOP      3328
#define XB_TOPGEN   3392
#define XCD_BAR_WORDS 3456
#define XB_SPIN_CAP (1u << 18)
DI unsigned xb_ld(unsigned* p) { return __hip_atomic_load(p, __ATOMIC_RELAXED, __HIP_MEMORY_SCOPE_AGENT); }
DI unsigned xb_add(unsigned* p, unsigned v) { return __hip_atomic_fetch_add(p, v, __ATOMIC_RELAXED, __HIP_MEMORY_SCOPE_AGENT); }
DI unsigned xb_xcc_id() { return (unsigned)__builtin_amdgcn_s_getreg((3 << 11) | 20) & 0xFu; }
#define XB_SPIN(cond, bar) do { unsigned _sp = 0; while (cond) { __builtin_amdgcn_s_sleep(1); \
    if ((++_sp & 255u) == 0u) { if (xb_ld(&(bar)[XB_TMO])) break; if (_sp > XB_SPIN_CAP) { atomicAdd(&(bar)[XB_TMO], 1u); break; } } } } while (0)
struct XcdBarrier { unsigned* bar; unsigned x; };
DI XcdBarrier xcd_barrier_post(unsigned* bar) {
  XcdBarrier b; b.bar = bar; b.x = xb_xcc_id();
  if (threadIdx.x == 0) (void)xb_add(&bar[XB_XCNT(b.x)], 1u);
  return b;
}
DI void xcd_barrier_complete(unsigned* bar, unsigned x, unsigned& nloc, unsigned& nx) {
  const unsigned G = gridDim.x * gridDim.y * gridDim.z;
  unsigned sum, cnt, mine, sp = 0u;
  for (;;) {
    sum = 0u; cnt = 0u; mine = 0u;
#pragma unroll
    for (unsigned j = 0; j < 16; ++j) { const unsigned c = xb_ld(&bar[XB_XCNT(j)]); sum += c; cnt += (c > 0u) ? 1u : 0u; mine = (j == x) ? c : mine; }
    if (sum == G) break;
    __builtin_amdgcn_s_sleep(1);
    if ((++sp & 255u) == 0u) { if (xb_ld(&bar[XB_TMO])) break; if (sp > XB_SPIN_CAP) { atomicAdd(&bar[XB_TMO], 1u); break; } }
  }
  nloc = mine > 0u ? mine : 1u; nx = cnt > 0u ? cnt : 1u;
}
DI void xcd_barrier(const XcdBarrier& b, volatile unsigned* st) {
  asm volatile("s_waitcnt vmcnt(0)" ::: "memory");
  __syncthreads();
  if (threadIdx.x == 0) {
    unsigned* bar = b.bar;
    const unsigned bx = xb_xcc_id();
    __builtin_amdgcn_s_waitcnt(0);
    unsigned nloc = st[0], nx = st[1];
    if (nloc == 0u) { xcd_barrier_complete(bar, bx, nloc, nx); st[0] = nloc; st[1] = nx; }
    const unsigned old = xb_add(&bar[XB_XSUB(bx)], 1u);
    const unsigned gen = old / nloc;
    if (old + 1u == (gen + 1u) * nloc) {
      __builtin_amdgcn_fence(__ATOMIC_RELEASE, "agent");
      asm volatile("s_waitcnt vmcnt(0)" ::: "memory");
      const unsigned og = xb_add(&bar[XB_TOP], 1u);
      const unsigned tg = og / nx;
      if (og + 1u == (tg + 1u) * nx) xb_add(&bar[XB_TOPGEN], 1u);
      else XB_SPIN(xb_ld(&bar[XB_TOPGEN]) == tg, bar);
      __builtin_amdgcn_fence(__ATOMIC_ACQUIRE, "agent");
      xb_add(&bar[XB_XGEN(bx)], 1u);
      asm volatile("s_waitcnt vmcnt(0)" ::: "memory");
    } else {
      XB_SPIN(xb_ld(&bar[XB_XGEN(bx)]) == gen, bar);
      __builtin_amdgcn_fence(__ATOMIC_ACQUIRE, "agent");
      asm volatile("s_waitcnt vmcnt(0)" ::: "memory");
    }
  }
  __syncthreads();
}

DI void phase_ogla(const Params& p, char* lds, int l) {
  const int tid = opaque_tid(), lane = tid & 63, r = lane & 31, h = lane >> 5;
  const int wave = __builtin_amdgcn_readfirstlane(tid >> 6), hh = wave >> 1, tb = wave & 1;
  const bfu* qs = (const bfu*)(p.ws + WS_QS); const bfu* ub = (const bfu*)(p.ws + WS_U);
  const bfu* proj = (const bfu*)(p.ws + WS_PROJ); bfu* mix = (bfu*)(p.ws + WS_H);
  const float* gg = p.gla_g + l * 128;
  for (int it = blockIdx.x; it < BATCH * NCH; it += gridDim.x) {
    const int b = it >> 8, c = it & 255;
    const size_t row = (size_t)b * SEQ + c * 64 + tb * 32 + r;
    bf16x8 qf[4];
#pragma unroll
    for (int ks = 0; ks < 4; ++ks) qf[ks] = *(const bf16x8*)(qs + row * 256 + hh * 64 + ks * 16 + h * 8);
    const bfu* sp = ub + (size_t)((b * NCH + c) * 4 + hh) * 8192;
    f32x16 O[4];
#pragma unroll
    for (int d = 0; d < 4; ++d) {
#pragma unroll
      for (int e = 0; e < 16; ++e) O[d][e] = 0.f;
#pragma unroll
      for (int ks = 0; ks < 4; ++ks) {
        const bf16x8 sf = *(const bf16x8*)(sp + (d * 32 + r) * 64 + ks * 16 + h * 8);
        O[d] = MFMA32(sf, qf[ks], O[d]);
      }
    }
    float ss = 0.f;
#pragma unroll
    for (int d = 0; d < 4; ++d)
#pragma unroll
      for (int e = 0; e < 16; ++e) ss += O[d][e] * O[d][e];
    ss += __shfl_xor(ss, 32);
    const float rstd = rsqrtf(ss * (1.f / 128.f) + EPS);
    char* stg = lds + wave * 16896;
    asm volatile("s_waitcnt lgkmcnt(0)" ::: "memory");
#pragma unroll
    for (int d = 0; d < 4; ++d)
#pragma unroll
      for (int g = 0; g < 4; ++g) {
        float4 o; o.x = O[d][4 * g] * rstd; o.y = O[d][4 * g + 1] * rstd; o.z = O[d][4 * g + 2] * rstd; o.w = O[d][4 * g + 3] * rstd;
        *(float4*)(stg + r * 528 + (d * 32 + 8 * g + 4 * h) * 4) = o;
      }
    asm volatile("s_waitcnt lgkmcnt(0)" ::: "memory");
    const size_t row0 = (size_t)b * SEQ + c * 64 + tb * 32;
#pragma unroll
    for (int it2 = 0; it2 < 16; ++it2) {
      const int id = it2 * 64 + lane, rr = id >> 5, cc = id & 31;
      const float4 v = *(const float4*)(stg + rr * 528 + cc * 16);
      const uint2 zr = *(const uint2*)(proj + (row0 + rr) * NP + C_GZ + hh * 128 + cc * 4);
      const float4 gv = *(const float4*)(gg + cc * 4);
      const float z0 = bf2f(zr.x & 0xffffu), z1 = __uint_as_float(zr.x & 0xffff0000u), z2 = bf2f(zr.y & 0xffffu), z3 = __uint_as_float(zr.y & 0xffff0000u);
      uint2 o;
      o.x = cvtpk(v.x * gv.x * silu_f(z0), v.y * gv.y * silu_f(z1));
      o.y = cvtpk(v.z * gv.z * silu_f(z2), v.w * gv.w * silu_f(z3));
      *(uint2*)(mix + (row0 + rr) * 1024 + hh * 128 + cc * 4) = o;
    }
  }
}

DI void scan_items(const Params& p) {
  const int tid = opaque_tid();
  bfu* ub = (bfu*)(p.ws + WS_U); const float* ab = (const float*)(p.ws + WS_A);
  if (tid < 256) {
    for (int it = blockIdx.x; it < 256; it += gridDim.x) {
      const int e = it * 256 + tid, b = e >> 15, rem = e & 32767, hh = rem >> 13, dk = rem & 63;
      bfu* up = ub + (size_t)b * NCH * 32768 + rem;
      const float* ap = ab + (size_t)b * NCH * 256 + hh * 64 + dk;
      float st = 0.f;
      for (int c0 = 0; c0 < NCH; c0 += 32) {
        bfu uv[32]; float av[32];
#pragma unroll
        for (int i = 0; i < 32; ++i) { uv[i] = up[(size_t)(c0 + i) * 32768]; av[i] = ap[(c0 + i) * 256]; }
#pragma unroll
        for (int i = 0; i < 32; ++i) { st = av[i] * st + bf2f(uv[i]); up[(size_t)(c0 + i) * 32768] = f2bf(st); }
      }
    }
  }
}

DI void attn_item(const Params& p, char* lds, int l, int bh, int jt, float lam, float outscale) {
  const int tid = opaque_tid(), lane = tid & 63, r = lane & 31, h = lane >> 5;
  const int wave = __builtin_amdgcn_readfirstlane(tid >> 6);
  const bfu* Kg = (const bfu*)(p.ws + WS_KN) + (size_t)bh * SEQ * 128;
  const bfu* Qg = (const bfu*)(p.ws + WS_QN) + (size_t)bh * SEQ * 128;
  const bfu* Vg = (const bfu*)(p.ws + WS_VT) + (size_t)bh * 128 * SEQ;
  const int nkt = 4 * jt + 4, my_last = 4 * jt + (wave >> 1);
  const int qrow = jt * 256 + wave * 32 + r;
  const int krow_l = 4 * wave + (lane >> 4), kp = lane & 15;
  const bfu* kgp = Kg + (size_t)krow_l * 128 + ((kp ^ (krow_l & 15)) * 8);
  const int vrow_l = 8 * wave + (lane >> 3), vp = lane & 7;
  const bfu* vgp = Vg + (size_t)vrow_l * SEQ + ((vp ^ ((vrow_l >> 1) & 7)) * 8);
  const unsigned lds0 = (unsigned)(uintptr_t)lds;
  const unsigned dk0 = (unsigned)__builtin_amdgcn_readfirstlane(lds0 + wave * 1024);
#define DMA_TILE(kt_, so_) do { glds16(kgp + (size_t)(kt_) * 64 * 128, dk0 + (so_)); glds16(kgp + (size_t)(kt_) * 64 * 128 + 32 * 128, dk0 + (so_) + 8192); \
    glds16(vgp + (kt_) * 64, dk0 + (so_) + 16384); glds16(vgp + (size_t)64 * SEQ + (kt_) * 64, dk0 + (so_) + 24576); } while (0)
  WAIT_BAR0();
  DMA_TILE(0, 0);
  char* q1s = lds + 65536 + tid * 16;
#pragma unroll
  for (int ks = 0; ks < 4; ++ks) {
    *(bf16x8*)(q1s + 32768 + ks * 8192) = *(const bf16x8*)(Qg + (size_t)qrow * 128 + ks * 16 + h * 8);
    *(bf16x8*)(q1s + ks * 8192) = *(const bf16x8*)(Qg + (size_t)qrow * 128 + 64 + ks * 16 + h * 8);
  }
  f32x16 O0[4], O1[4];
#pragma unroll
  for (int d = 0; d < 4; ++d)
#pragma unroll
    for (int e = 0; e < 16; ++e) { O0[d][e] = 0.f; O1[d][e] = 0.f; }
  float l0 = 0.f, l1 = 0.f;
  const int pr = pi_row(r);
  const unsigned kb = pr * 256 + (((pr & 15) ^ h) << 4);
  const unsigned vb = 16384 + r * 128 + ((((r >> 1) & 7) ^ h) << 4);
  for (int kt = 0; kt < nkt; ++kt) {
    WAIT_BAR0();
    const unsigned so = (kt & 1) * 32768;
    if (kt + 1 < nkt) DMA_TILE(kt + 1, 32768 - so);
    if (kt <= my_last) {
#define KFRAG(sub_, mp_, ks_) (*(const bf16x8*)(lds + ((kb + so + (sub_) * 8192) ^ (unsigned)((((mp_) * 8) + (ks_) * 2) << 4))))
#define VFRAG(sub_, d_, s_) (*(const bf16x8*)(lds + ((vb + so + (d_) * 4096) ^ (unsigned)(((sub_) * 4 + (s_) * 2) << 4))))
#define QFRAG(mp_, ks_) (*(const bf16x8*)(q1s + ((mp_) ? 0 : 32768) + (ks_) * 8192))
#define SOFTMAX_PACK(S_, P_, l_) do { _Pragma("unroll") for (int e = 0; e < 16; ++e) { S_[e] = __builtin_amdgcn_exp2f(S_[e]); l_ += S_[e]; } \
        _Pragma("unroll") for (int s = 0; s < 2; ++s) { u32x4 a_; _Pragma("unroll") for (int q = 0; q < 4; ++q) a_[q] = cvtpk(S_[8 * s + 2 * q], S_[8 * s + 2 * q + 1]); P_[s] = __builtin_bit_cast(bf16x8, a_); } } while (0)
      bf16x8 pa0[2], pa1[2];
      f32x16 S0, S1;
#pragma unroll
      for (int e = 0; e < 16; ++e) { S0[e] = 0.f; S1[e] = 0.f; }
#pragma unroll
      for (int ks = 0; ks < 4; ++ks) {
        S0 = MFMA32(KFRAG(0, 0, ks), QFRAG(0, ks), S0);
        S1 = MFMA32(KFRAG(0, 1, ks), QFRAG(1, ks), S1);
      }
      SOFTMAX_PACK(S0, pa0, l0);
      SOFTMAX_PACK(S1, pa1, l1);
#pragma unroll
      for (int e = 0; e < 16; ++e) { S0[e] = 0.f; S1[e] = 0.f; }
#pragma unroll
      for (int ks = 0; ks < 4; ++ks) {
        S0 = MFMA32(KFRAG(1, 0, ks), QFRAG(0, ks), S0);
        S1 = MFMA32(KFRAG(1, 1, ks), QFRAG(1, ks), S1);
#pragma unroll
        for (int dd = 0; dd < 2; ++dd) {
          const int d = (ks & 1) * 2 + dd, s = ks >> 1;
          const bf16x8 vf = VFRAG(0, d, s);
          O0[d] = MFMA32(vf, pa0[s], O0[d]);
          O1[d] = MFMA32(vf, pa1[s], O1[d]);
        }
      }
      bf16x8 pc0[2], pc1[2];
      SOFTMAX_PACK(S0, pc0, l0);
      SOFTMAX_PACK(S1, pc1, l1);
#pragma unroll
      for (int s = 0; s < 2; ++s) {
#pragma unroll
        for (int d = 0; d < 4; ++d) {
          const bf16x8 vf = VFRAG(1, d, s);
          O0[d] = MFMA32(vf, pc0[s], O0[d]);
          O1[d] = MFMA32(vf, pc1[s], O1[d]);
        }
      }
#undef KFRAG
#undef VFRAG
#undef QFRAG
#undef SOFTMAX_PACK
    }
  }
#undef DMA_TILE
  l0 += __shfl_xor(l0, 32); l1 += __shfl_xor(l1, 32);
  const float i0 = 1.f / l0, i1 = -lam / l1;
  float ss = 0.f;
#pragma unroll
  for (int d = 0; d < 4; ++d)
#pragma unroll
    for (int e = 0; e < 16; ++e) { const float o = O0[d][e] * i0 + O1[d][e] * i1; O0[d][e] = o; ss += o * o; }
  ss += __shfl_xor(ss, 32);
  const float rstd = rsqrtf(ss * (1.f / 128.f) + EPS) * outscale;
  const int b = bh >> 2, hh = bh & 3;
  const size_t row = (size_t)b * SEQ + qrow;
  const bfu* zp = (const bfu*)(p.ws + WS_PROJ) + row * NP + C_DZ + hh * 128;
  bfu* mp = (bfu*)(p.ws + WS_H) + row * 1024 + 512 + hh * 128;
  const float* gd = p.diff_g + l * 128;
#pragma unroll
  for (int d = 0; d < 4; ++d)
#pragma unroll
    for (int g = 0; g < 4; ++g) {
      const int dv = d * 32 + 8 * g + 4 * h;
      const uint2 zr = *(const uint2*)(zp + dv);
      const float4 gv = *(const float4*)(gd + dv);
      const float z0 = bf2f(zr.x & 0xffffu), z1 = __uint_as_float(zr.x & 0xffff0000u), z2 = bf2f(zr.y & 0xffffu), z3 = __uint_as_float(zr.y & 0xffff0000u);
      uint2 o;
      o.x = cvtpk(O0[d][4 * g] * rstd * gv.x * silu_f(z0), O0[d][4 * g + 1] * rstd * gv.y * silu_f(z1));
      o.y = cvtpk(O0[d][4 * g + 2] * rstd * gv.z * silu_f(z2), O0[d][4 * g + 3] * rstd * gv.w * silu_f(z3));
      *(uint2*)(mp + dv) = o;
    }
}

DI void phase_attn(const Params& p, char* lds, int l) {
  scan_items(p);
  const float lam = ((const float*)(p.ws + WS_LAM))[l];
  const float outscale = 1.f - p.lam_init[l];
  unsigned* scnt = (unsigned*)(p.ws + WS_BAR) + 3584;
  asm volatile("s_waitcnt vmcnt(0)" ::: "memory");
  __syncthreads();
  if (threadIdx.x == 0) {
    __builtin_amdgcn_fence(__ATOMIC_RELEASE, "agent");
    asm volatile("s_waitcnt vmcnt(0)" ::: "memory");
    (void)xb_add(scnt, 1u);
  }
  if (__builtin_amdgcn_readfirstlane(threadIdx.x) >= 256) __builtin_amdgcn_s_setprio(1);
  for (int pr = blockIdx.x; pr < 256; pr += gridDim.x) {
    const int bh = pr & 7, jj = pr >> 3;
#pragma unroll 1
    for (int rep = 0; rep < 2; ++rep) attn_item(p, lds, l, bh, rep ? jj : 63 - jj, lam, outscale);
  }
  __builtin_amdgcn_s_setprio(0);
  if (threadIdx.x == 0) {
    const unsigned target = gridDim.x * (unsigned)(l + 1);
    unsigned sp = 0;
    while (xb_ld(scnt) < target) { __builtin_amdgcn_s_sleep(1); if (++sp > (1u << 22)) break; }
    __builtin_amdgcn_fence(__ATOMIC_ACQUIRE, "agent");
    asm volatile("s_waitcnt vmcnt(0)" ::: "memory");
  }
  __syncthreads();
  phase_ogla(p, lds, l);
}

__global__ void __launch_bounds__(NT) fwd_megakernel(Params p) {
  extern __shared__ __attribute__((aligned(16))) char lds[];
  cg::grid_group grid = cg::this_grid();
  volatile unsigned* xst = (volatile unsigned*)(lds + LDS_BYTES);
  if (threadIdx.x == 0) { xst[0] = 0u; xst[1] = 0u; }
  __syncthreads();
  const XcdBarrier xbar = xcd_barrier_post((unsigned*)(p.ws + WS_BAR));
#define GBAR() xcd_barrier(xbar, (volatile unsigned*)(lds + LDS_BYTES))
  p0_prologue(p, lds);
  grid.sync();
  {
    const int wv = __builtin_amdgcn_readfirstlane(threadIdx.x >> 6);
#pragma unroll 1
    for (int step = 0; step < 2; ++step) { if ((step ^ wv) & 1) p0_tiles(p, lds); else phase_norm(p, 0, p.x); }
  }
  GBAR();
#pragma unroll 1
  for (int l = 0; l < DEPTH; ++l) {
    const float* xin = (l == 0) ? p.x : p.out;
    if (l > 0) { phase_norm(p, l, xin); GBAR(); }
    gemm_phase<0>(p, lds, (const bfu*)(p.ws + WS_H), (const bfu*)(p.ws + WS_WINT) + (size_t)l * NP * 1024, 14, l, nullptr);
    GBAR();
    phase_prep(p, lds, l);
    GBAR();
    phase_attn(p, lds, l);
    GBAR();
    gemm_phase<1>(p, lds, (const bfu*)(p.ws + WS_H), (const bfu*)(p.ws + WS_WOUTT) + (size_t)l * 1024 * 1024, 4, l, xin);
    if (l + 1 < DEPTH) GBAR();
  }
#undef GBAR
}

#ifndef MK_SPLIT
#define MK_SPLIT 0
#endif

extern "C" void kernel_launch(void* const* d_in, const int* in_sizes, int n_in, void* d_out, int out_size, void* d_ws, size_t ws_size, hipStream_t stream) {
  static int grid_blocks = 0;
  if (!grid_blocks) {
    if (ws_size < WS_END) { fprintf(stderr, "kernel_launch: workspace too small: %zu < %zu\n", ws_size, (size_t)WS_END); grid_blocks = -1; return; }
    int dev = 0, cus = 0, per_cu = 0;
    hipGetDevice(&dev);
    hipDeviceGetAttribute(&cus, hipDeviceAttributeMultiprocessorCount, dev);
    hipFuncSetAttribute((const void*)fwd_megakernel, hipFuncAttributeMaxDynamicSharedMemorySize, LDS_BYTES + 16);
    hipOccupancyMaxActiveBlocksPerMultiprocessor(&per_cu, (const void*)fwd_megakernel, NT, LDS_BYTES + 16);
    if (per_cu < 1) per_cu = 1;
    if (per_cu > 1) per_cu = 1;
    grid_blocks = cus * per_cu;
  }
  if (grid_blocks < 0) return;
  Params p{};
  p.x = (const float*)d_in[0]; p.c = (const float*)d_in[1]; p.w_ada = (const float*)d_in[2]; p.b_ada = (const float*)d_in[3];
  p.norm_g = (const float*)d_in[4]; p.w_in = (const float*)d_in[5]; p.conv_w = (const float*)d_in[6]; p.w_gk = (const float*)d_in[7];
  p.b_gk = (const float*)d_in[8]; p.gla_g = (const float*)d_in[9]; p.qn_g = (const float*)d_in[10]; p.kn_g = (const float*)d_in[11];
  p.lq1 = (const float*)d_in[12]; p.lk1 = (const float*)d_in[13]; p.lq2 = (const float*)d_in[14]; p.lk2 = (const float*)d_in[15];
  p.diff_g = (const float*)d_in[16]; p.w_out = (const float*)d_in[17];
  p.out = (float*)d_out; p.ws = (unsigned char*)d_ws;
  const double li[4] = {0.8 - 0.6 * 1.0, 0.8 - 0.6 * 0.7408182206817179, 0.8 - 0.6 * 0.5488116360940264, 0.8 - 0.6 * 0.4065696597405991};
  for (int l = 0; l < 4; ++l) p.lam_init[l] = (float)li[l];
  hipMemsetAsync((char*)d_ws + WS_BAR, 0, 16384, stream);
  constexpr int NPH = 2 + 6 * DEPTH;
  void* args[] = {&p};
  hipError_t e = hipLaunchCooperativeKernel((void*)fwd_megakernel, dim3(grid_blocks), dim3(NT), args, LDS_BYTES + 16, stream);
  if (e != hipSuccess) fprintf(stderr, "cooperative launch failed: %s (grid %d)\n", hipGetErrorString(e), grid_blocks);
}
```

```cpp
#include <hip/hip_runtime.h>
#include <hip/hip_bf16.h>
#include <hip/hip_cooperative_groups.h>
#include <cstdio>
#include <cstdint>
namespace cg = cooperative_groups;

#define DI __device__ __forceinline__
typedef unsigned short bfu;
using bf16x8 = __attribute__((ext_vector_type(8))) short;
using f32x16 = __attribute__((ext_vector_type(16))) float;
using u32x4  = __attribute__((ext_vector_type(4))) unsigned;
#define MFMA32(a, b, c) __builtin_amdgcn_mfma_f32_32x32x16_bf16((a), (b), (c), 0, 0, 0)

constexpr int D = 1024, BATCH = 2, SEQ = 16384, DEPTH = 4, T = BATCH * SEQ;
constexpr int NCH = SEQ / 64;
constexpr int INW = 3600, NP = 3840;
constexpr int C_GQ = 0, C_GK = 256, C_GV = 512, C_GZ = 1024, C_DQ = 1536, C_DK = 2048, C_DV = 2560, C_DZ = 3072, C_GLR = 3584;
constexpr float EPS = 1e-6f;
constexpr float LOG2E = 1.4426950408889634f;
constexpr int NT = 512;
constexpr int LDS_BYTES = 139264;

constexpr size_t WS_WINT = 0;
constexpr size_t WS_WOUTT = WS_WINT + (size_t)DEPTH * NP * D * 2;
constexpr size_t WS_MODP = WS_WOUTT + (size_t)DEPTH * D * D * 2;
constexpr size_t WS_MOD = WS_MODP + (size_t)DEPTH * 8 * 2 * 3072 * 4;
constexpr size_t WS_LAM = WS_MOD + (size_t)DEPTH * 2 * 3072 * 4;
constexpr size_t WS_H = WS_LAM + 256;
constexpr size_t WS_PROJ = WS_H + (size_t)T * D * 2;
constexpr size_t WS_U = WS_PROJ + (size_t)T * NP * 2;
constexpr size_t WS_A = WS_U + (size_t)BATCH * NCH * 4 * 8192 * 2;
constexpr size_t WS_QS = WS_A + (size_t)BATCH * NCH * 256 * 4;
constexpr size_t WS_QN = WS_QS + (size_t)T * 256 * 2;
constexpr size_t WS_KN = WS_QN + (size_t)T * 512 * 2;
constexpr size_t WS_VT = WS_KN + (size_t)T * 512 * 2;
constexpr size_t WS_BAR = WS_VT + (size_t)T * 512 * 2;
constexpr size_t WS_END = WS_BAR + 16384;

struct Params {
  const float *x, *c, *w_ada, *b_ada, *norm_g, *w_in, *conv_w, *w_gk, *b_gk, *gla_g, *qn_g, *kn_g, *lq1, *lk1, *lq2, *lk2, *diff_g, *w_out;
  float* out; unsigned char* ws;
  float lam_init[4];
  int ph_lo, ph_hi;
};

DI int opaque_tid() { int t = threadIdx.x; asm volatile("" : "+v"(t)); return t; }
DI float bf2f(unsigned u) { return __uint_as_float(u << 16); }
typedef __bf16 bf16x2_t __attribute__((ext_vector_type(2)));
typedef float f32x2_t __attribute__((ext_vector_type(2)));
DI unsigned cvtpk(float lo, float hi) { f32x2_t v = {lo, hi}; bf16x2_t r = __builtin_convertvector(v, bf16x2_t); return __builtin_bit_cast(unsigned, r); }
DI bfu f2bf(float x) { return (bfu)(cvtpk(x, 0.f) & 0xffffu); }
DI float silu_f(float x) { return x * __builtin_amdgcn_rcpf(1.f + __expf(-x)); }
DI int crow(int reg, int h) { return (reg & 3) + 8 * (reg >> 2) + 4 * h; }
DI int pi_row(int r) { return (r & ~12) | ((r & 4) << 1) | ((r & 8) >> 1); }
DI float wave_sum(float v) {
#pragma unroll
  for (int o = 32; o >= 1; o >>= 1) v += __shfl_xor(v, o);
  return v;
}

DI void glds16(const void* g, unsigned lds_base) {
  unsigned sv; asm volatile("s_mov_b32 %0, m0\n\ts_mov_b32 m0, %2\n\ts_nop 0\n\tglobal_load_lds_dwordx4 %1, off\n\ts_mov_b32 m0, %0" : "=&s"(sv) : "v"(g), "s"(lds_base) : "memory"); }
#define WAIT_BAR0() asm volatile("s_waitcnt vmcnt(0) lgkmcnt(0)\n\ts_barrier" ::: "memory")


DI void p0_prologue(const Params& p, char* lds) {
  const int tid = opaque_tid(), lane = tid & 63;
  const int wave = __builtin_amdgcn_readfirstlane(tid >> 6);
  bfu* WinT = (bfu*)(p.ws + WS_WINT); bfu* WoutT = (bfu*)(p.ws + WS_WOUTT);
  float* lamv = (float*)(p.ws + WS_LAM);
  constexpr int N_MOD = DEPTH * 48;
  {
    float* red = (float*)lds;
    for (int it = blockIdx.x; it < N_MOD + 1; it += gridDim.x) {
      if (it < N_MOD) {
        const int l = it / 48, jb = it % 48;
        const int j = lane, ks = wave;
        float a0 = 0.f, a1 = 0.f;
        const float* wp = p.w_ada + (size_t)(l * 1024 + ks * 128) * 3072 + jb * 64 + j;
        const float* cp = p.c + ks * 128;
#pragma unroll 32
        for (int k = 0; k < 128; ++k) { const float w = wp[(size_t)k * 3072]; a0 += silu_f(cp[k]) * w; a1 += silu_f(cp[1024 + k]) * w; }
        red[(ks * 2 + 0) * 64 + j] = a0; red[(ks * 2 + 1) * 64 + j] = a1;
        __syncthreads();
        if (tid < 128) {
          const int b = tid >> 6;
          float acc = p.b_ada[l * 3072 + jb * 64 + j];
#pragma unroll
          for (int q = 0; q < 8; ++q) acc += red[(q * 2 + b) * 64 + j];
          ((float*)(p.ws + WS_MOD))[(l * 2 + b) * 3072 + jb * 64 + j] = acc;
        }
        __syncthreads();
      } else if (tid < 64) {
        for (int l = 0; l < DEPTH; ++l) {
          float s1 = p.lq1[l * 64 + tid] * p.lk1[l * 64 + tid], s2 = p.lq2[l * 64 + tid] * p.lk2[l * 64 + tid];
          s1 = wave_sum(s1); s2 = wave_sum(s2);
          if (tid == 0) lamv[l] = expf(s1) - expf(s2) + p.lam_init[l];
        }
      }
    }
  }
}

DI void p0_tiles(const Params& p, char* lds) {
  const int tid = opaque_tid(), lane = tid & 63;
  const int wave = __builtin_amdgcn_readfirstlane(tid >> 6);
  bfu* WinT = (bfu*)(p.ws + WS_WINT); bfu* WoutT = (bfu*)(p.ws + WS_WOUTT);
  {
    constexpr int N_IN = DEPTH * 16 * 57, N_OUT = DEPTH * 16 * 16;
    float* tile = (float*)(lds + wave * 16640);
    for (int it = blockIdx.x * 8 + wave; it < N_IN + N_OUT; it += gridDim.x * 8) {
      const bool isin = it < N_IN;
      int l, kt, nt;
      if (isin) { l = it / (16 * 57); int rr = it % (16 * 57); nt = rr / 16; kt = rr % 16; }
      else { int r2 = it - N_IN; l = r2 / 256; int rr = r2 % 256; nt = rr / 16; kt = rr % 16; }
      const int k0 = kt * 64, n0 = nt * 64;
      const int np = n0 + lane;
      const int on = np < 1024 ? np : (np < 3584 ? np + 16 : (np < 3600 ? np - 3584 + 1024 : -1));
      const float* srcp = isin ? (p.w_in + (size_t)(l * 1024 + k0) * INW + (on >= 0 ? on : 0)) : (p.w_out + (size_t)(l * 1024 + k0) * 1024 + n0 + lane);
      const size_t pitch = isin ? INW : 1024;
      const bool live = !isin || on >= 0;
      float v[64];
#pragma unroll
      for (int kk = 0; kk < 64; ++kk) v[kk] = live ? srcp[(size_t)kk * pitch] : 0.f;
      asm volatile("s_waitcnt lgkmcnt(0)" ::: "memory");
#pragma unroll
      for (int kk = 0; kk < 64; ++kk) tile[kk * 65 + lane] = v[kk];
      asm volatile("s_waitcnt lgkmcnt(0)" ::: "memory");
#pragma unroll
      for (int q = 0; q < 8; ++q) {
        const int nn = q * 8 + (lane >> 3), kc = lane & 7;
        const float* tp = tile + (kc * 8) * 65 + nn;
        uint4 o; o.x = cvtpk(tp[0], tp[65]); o.y = cvtpk(tp[130], tp[195]); o.z = cvtpk(tp[260], tp[325]); o.w = cvtpk(tp[390], tp[455]);
        bfu* dst = isin ? (WinT + ((size_t)l * NP + n0 + nn) * 1024 + k0 + kc * 8) : (WoutT + ((size_t)l * 1024 + n0 + nn) * 1024 + k0 + kc * 8);
        *(uint4*)dst = o;
      }
    }
  }
}

DI void phase_norm(const Params& p, int l, const float* xin) {
  const int tid = opaque_tid(), lane = tid & 63, wave = tid >> 6;
  const float* g = p.norm_g + l * 1024; const float* md = (const float*)(p.ws + WS_MOD) + l * 6144;
  bfu* hb = (bfu*)(p.ws + WS_H);
  for (int r0 = (blockIdx.x * 8 + wave) * 16; r0 < T; r0 += gridDim.x * 8 * 16) {
    const int b = r0 >> 14;
    float4 ga[4], sh[4];
#pragma unroll
    for (int i = 0; i < 4; ++i) {
      const int k = (lane + 64 * i) * 4;
      const float4 g4 = *(const float4*)(g + k), sc = *(const float4*)(md + b * 3072 + 1024 + k);
      sh[i] = *(const float4*)(md + b * 3072 + k);
      ga[i].x = g4.x * (1.f + sc.x); ga[i].y = g4.y * (1.f + sc.y); ga[i].z = g4.z * (1.f + sc.z); ga[i].w = g4.w * (1.f + sc.w);
    }
#pragma unroll 1
    for (int rg = 0; rg < 16; rg += 4) {
      float4 v[4][4];
#pragma unroll
      for (int q = 0; q < 4; ++q) {
        const float4* xr = (const float4*)(xin + (size_t)(r0 + rg + q) * 1024);
#pragma unroll
        for (int i = 0; i < 4; ++i) v[q][i] = xr[lane + 64 * i];
      }
#pragma unroll
      for (int q = 0; q < 4; ++q) {
        float ss = 0.f;
#pragma unroll
        for (int i = 0; i < 4; ++i) ss += v[q][i].x * v[q][i].x + v[q][i].y * v[q][i].y + v[q][i].z * v[q][i].z + v[q][i].w * v[q][i].w;
        ss = wave_sum(ss);
        const float rstd = rsqrtf(ss * (1.f / 1024.f) + EPS);
#pragma unroll
        for (int i = 0; i < 4; ++i) {
          const int k = (lane + 64 * i) * 4;
          const float o0 = v[q][i].x * rstd * ga[i].x + sh[i].x, o1 = v[q][i].y * rstd * ga[i].y + sh[i].y;
          const float o2 = v[q][i].z * rstd * ga[i].z + sh[i].z, o3 = v[q][i].w * rstd * ga[i].w + sh[i].w;
          uint2 o; o.x = cvtpk(o0, o1); o.y = cvtpk(o2, o3);
          *(uint2*)(hb + (size_t)(r0 + rg + q) * 1024 + k) = o;
        }
      }
    }
  }
}

DI void tile_map(int idx, int ntn, int& tm, int& tn) {
  const int xcd = idx & 7, li = idx >> 3, g4 = 4 * ntn, g = li / g4, rem = li - g * g4;
  tn = rem >> 2; tm = xcd * 16 + g * 4 + (rem & 3);
}
template <int EPI>
DI void gemm_phase(const Params& p, char* lds, const bfu* __restrict__ A, const bfu* __restrict__ BT, int ntn, int l, const float* xin) {
  const int tid = opaque_tid(), lane = tid & 63, r = lane & 31, h = lane >> 5;
  const int wave = __builtin_amdgcn_readfirstlane(tid >> 6), wm = wave >> 1, wn = wave & 1;
  const int drow = 8 * wave + (lane >> 3);
  const int dsrc = drow * 1024 + (((lane & 7) ^ ((drow >> 1) & 7)) << 3);
  const unsigned lds0 = (unsigned)(uintptr_t)lds;
  const unsigned dd0 = (unsigned)__builtin_amdgcn_readfirstlane(lds0 + wave * 1024);
  const int swz = (r >> 1) & 7;
  const int ntiles = (T / 256) * ntn;
#define DMA_SLAB(Ap, Bp, kk, so) do { const bfu* a_ = (Ap) + dsrc + (kk) * 64; const bfu* b_ = (Bp) + dsrc + (kk) * 64; \
      _Pragma("unroll") for (int q_ = 0; q_ < 4; ++q_) { glds16(a_ + q_ * 64 * 1024, dd0 + (so) + q_ * 8192); glds16(b_ + q_ * 64 * 1024, dd0 + (so) + 32768 + q_ * 8192); } } while (0)
#define SBAR() __builtin_amdgcn_sched_barrier(0)
#define WSYNC() asm volatile("s_waitcnt lgkmcnt(0)" ::: "memory")
#define DMA_PIECE(Ap, Bp, kk, so, pz) glds16((((pz) < 4) ? (Ap) : (Bp)) + dsrc + (kk) * 64 + ((pz) & 3) * 64 * 1024, dd0 + (so) + ((pz) < 4 ? 0 : 32768) + ((pz) & 3) * 8192)
  WAIT_BAR0();
  if ((int)blockIdx.x < ntiles) {
    int tm, tn; tile_map((int)blockIdx.x, ntn, tm, tn);
    DMA_SLAB(A + (size_t)tm * 256 * 1024, BT + (size_t)tn * 256 * 1024, 0, 0);
  }
  WAIT_BAR0();
  for (int tile = blockIdx.x; tile < ntiles; tile += gridDim.x) {
    int tm, tn; tile_map(tile, ntn, tm, tn);
    const int m0 = tm * 256, n0 = tn * 256;
    const int cls = (EPI == 0) ? ((tn >= 6 && tn < 8) ? 1 : (tn >= 8 && tn < 10) ? 2 : (tn >= 10 && tn < 12) ? 3 : 0) : 0;
    const bool vtm = cls == 3;
    const int wA = vtm ? (wave & 1) : wm, wB = vtm ? (wave >> 1) : wn;
    const bfu* Ag = A + (size_t)m0 * 1024;
    const bfu* Bg = BT + (size_t)n0 * 1024;
    f32x16 acc[2][4];
#pragma unroll
    for (int i = 0; i < 2; ++i)
#pragma unroll
      for (int j = 0; j < 4; ++j)
#pragma unroll
        for (int e = 0; e < 16; ++e) acc[i][j][e] = 0.f;
    const bfu* An = Ag; const bfu* Bn = Bg;
    {
      const int nt_ = tile + gridDim.x;
      if (nt_ < ntiles) { int tm2, tn2; tile_map(nt_, ntn, tm2, tn2); An = A + (size_t)tm2 * 256 * 1024; Bn = BT + (size_t)tn2 * 256 * 1024; }
    }
    for (int kt = 0; kt < 16; ++kt) {
      if (kt == 0) asm volatile("s_waitcnt lgkmcnt(0)\n\ts_barrier" ::: "memory"); else WAIT_BAR0();
      const unsigned so = (kt & 1) * 65536;
      const bool dnext = (kt + 1 < 16) || (tile + (int)gridDim.x < ntiles);
      const bfu* dA = (kt + 1 < 16) ? Ag : An; const bfu* dB = (kt + 1 < 16) ? Bg : Bn;
      const int dk = (kt + 1 < 16) ? kt + 1 : 0; const unsigned dso = (kt + 1 < 16) ? 65536 - so : 0;
      const char* sb = lds + so;
      const char* pa = sb + (vtm ? 32768 + (wB * 64 + r) * 128 : (wA * 64 + r) * 128);
      const char* pb = sb + (vtm ? (wA * 128 + r) * 128 : 32768 + (wB * 128 + r) * 128);
      bf16x8 af[2][2], bfr[2][4];
      {
        const unsigned co = (unsigned)((h ^ swz) << 4);
        af[0][0] = *(const bf16x8*)(pa + co); af[0][1] = *(const bf16x8*)(pa + 4096 + co);
#pragma unroll
        for (int j = 0; j < 4; ++j) bfr[0][j] = *(const bf16x8*)(pb + j * 4096 + co);
      }
#pragma unroll
      for (int s = 0; s < 4; ++s) {
        if (s < 3) {
          const unsigned co = (unsigned)((((s + 1) * 2 + h) ^ swz) << 4);
          af[(s + 1) & 1][0] = *(const bf16x8*)(pa + co); af[(s + 1) & 1][1] = *(const bf16x8*)(pa + 4096 + co);
#pragma unroll
          for (int j = 0; j < 4; ++j) bfr[(s + 1) & 1][j] = *(const bf16x8*)(pb + j * 4096 + co);
        }
        SBAR();
#pragma unroll
        for (int i = 0; i < 2; ++i)
#pragma unroll
          for (int j = 0; j < 4; ++j) {
            acc[i][j] = MFMA32(bfr[s & 1][j], af[s & 1][i], acc[i][j]);
            if (s < 2 && (j & 1) && dnext) DMA_PIECE(dA, dB, dk, dso, s * 4 + i * 2 + (j >> 1));
          }
        SBAR();
      }
    }
    WAIT_BAR0();
    if (EPI == 0) {
      char* stg = lds + 65536 + wave * 9216;
#pragma unroll
      for (int jp = 0; jp < 2; ++jp) {
        if (cls == 1 || cls == 2) {
          const float* gg = (cls == 1 ? p.qn_g : p.kn_g) + l * 64;
          const float post = (cls == 1) ? 0.125f * LOG2E : 1.f;
#pragma unroll
          for (int i = 0; i < 2; ++i) {
            float ss = 0.f;
#pragma unroll
            for (int j2 = 0; j2 < 2; ++j2)
#pragma unroll
              for (int e = 0; e < 16; ++e) ss += acc[i][2 * jp + j2][e] * acc[i][2 * jp + j2][e];
            ss += __shfl_xor(ss, 32);
            const float rs = rsqrtf(ss * (1.f / 64.f) + EPS) * post;
#pragma unroll
            for (int j2 = 0; j2 < 2; ++j2)
#pragma unroll
              for (int g = 0; g < 4; ++g) {
                const float4 gv = *(const float4*)(gg + j2 * 32 + 8 * g + 4 * h);
                f32x16& a = acc[i][2 * jp + j2];
                a[4 * g] *= rs * gv.x; a[4 * g + 1] *= rs * gv.y; a[4 * g + 2] *= rs * gv.z; a[4 * g + 3] *= rs * gv.w;
              }
          }
        }
        if (jp) WSYNC();
#pragma unroll
        for (int i = 0; i < 2; ++i)
#pragma unroll
          for (int j2 = 0; j2 < 2; ++j2)
#pragma unroll
            for (int g = 0; g < 4; ++g) {
              const f32x16& a = acc[i][2 * jp + j2];
              uint2 o; o.x = cvtpk(a[4 * g], a[4 * g + 1]); o.y = cvtpk(a[4 * g + 2], a[4 * g + 3]);
              *(uint2*)(stg + (i * 32 + r) * 144 + (j2 * 32 + 8 * g + 4 * h) * 2) = o;
            }
        WSYNC();
        const int nc0 = n0 + wn * 128 + jp * 64;
        bfu* dst; size_t pitch;
        if (cls == 0) { dst = (bfu*)(p.ws + WS_PROJ) + (size_t)(m0 + wm * 64) * NP + nc0; pitch = NP; }
        else if (cls == 3) {
          const int col0 = n0 + wB * 64 - C_DV, bh = (m0 >> 14) * 4 + (col0 >> 7);
          dst = (bfu*)(p.ws + WS_VT) + ((size_t)bh * 128 + (col0 & 127)) * SEQ + ((m0 + wA * 128 + jp * 64) & (SEQ - 1)); pitch = SEQ;
        } else {
          const int col0 = nc0 - (cls == 1 ? C_DQ : C_DK), bh = (m0 >> 14) * 4 + (col0 >> 7);
          dst = (bfu*)(p.ws + (cls == 1 ? WS_QN : WS_KN)) + ((size_t)bh * SEQ + ((m0 + wm * 64) & (SEQ - 1))) * 128 + ((col0 >> 6) & 1) * 64; pitch = 128;
        }
#pragma unroll
        for (int it = 0; it < 8; ++it) {
          const int id = it * 64 + lane, row = id >> 3, c = id & 7;
          const uint4 v = *(const uint4*)(stg + row * 144 + c * 16);
          *(uint4*)(dst + (size_t)row * pitch + c * 8) = v;
        }
      }
    } else {
      char* stg = lds + 65536 + wave * 8704;
      const float* gate = (const float*)(p.ws + WS_MOD) + l * 6144 + (m0 >> 14) * 3072 + 2048;
      float4 xn[8];
#define LOADX(ps_) do { _Pragma("unroll") for (int it = 0; it < 8; ++it) { const int id = it * 64 + lane, row = id >> 4, c = id & 15; \
          xn[it] = *(const float4*)(xin + (size_t)(m0 + wm * 64 + ((ps_) >> 1) * 32 + row) * 1024 + n0 + wn * 128 + ((ps_) & 1) * 64 + c * 4); } } while (0)
      LOADX(0);
#pragma unroll
      for (int ps = 0; ps < 4; ++ps) {
        const int i = ps >> 1, jp = ps & 1;
        float4 xc[8];
#pragma unroll
        for (int it = 0; it < 8; ++it) xc[it] = xn[it];
        if (ps + 1 < 4) LOADX(ps + 1);
        if (ps) WSYNC();
#pragma unroll
        for (int j2 = 0; j2 < 2; ++j2)
#pragma unroll
          for (int g = 0; g < 4; ++g) {
            const f32x16& a = acc[i][2 * jp + j2];
            float4 o; o.x = a[4 * g]; o.y = a[4 * g + 1]; o.z = a[4 * g + 2]; o.w = a[4 * g + 3];
            *(float4*)(stg + r * 272 + (j2 * 32 + 8 * g + 4 * h) * 4) = o;
          }
        WSYNC();
#pragma unroll
        for (int it = 0; it < 8; ++it) {
          const int id = it * 64 + lane, row = id >> 4, c = id & 15;
          const float4 y = *(const float4*)(stg + row * 272 + c * 16);
          const int m = m0 + wm * 64 + i * 32 + row, n = n0 + wn * 128 + jp * 64 + c * 4;
          const float4 xv = xc[it];
          const float4 gv = *(const float4*)(gate + n);
          float4 o; o.x = xv.x + gv.x * y.x; o.y = xv.y + gv.y * y.y; o.z = xv.z + gv.z * y.z; o.w = xv.w + gv.w * y.w;
          *(float4*)(p.out + (size_t)m * 1024 + n) = o;
        }
      }
#undef LOADX
    }
  }
#undef DMA_SLAB
#undef DMA_PIECE
#undef SBAR
#undef WSYNC
  if (EPI == 0) {
    using f32x4 = __attribute__((ext_vector_type(4))) float;
    bfu* proj = (bfu*)(p.ws + WS_PROJ);
    const int quad = lane >> 4, c16 = lane & 15;
    const bfu* wrow = BT + (size_t)(C_GLR + c16) * 1024 + quad * 8;
    for (int rb = blockIdx.x * 8 + wave; rb < T / 16; rb += gridDim.x * 8) {
      const bfu* hrow = A + (size_t)(rb * 16 + c16) * 1024 + quad * 8;
      f32x4 c4 = {0.f, 0.f, 0.f, 0.f};
#pragma unroll 8
      for (int ks = 0; ks < 32; ++ks) {
        const bf16x8 wf = *(const bf16x8*)(wrow + ks * 32);
        const bf16x8 hf = *(const bf16x8*)(hrow + ks * 32);
        c4 = __builtin_amdgcn_mfma_f32_16x16x32_bf16(wf, hf, c4, 0, 0, 0);
      }
      uint2 o; o.x = cvtpk(c4[0], c4[1]); o.y = cvtpk(c4[2], c4[3]);
      *(uint2*)(proj + (size_t)(rb * 16 + c16) * NP + C_GLR + quad * 4) = o;
    }
  }
}

DI void prep_gla_load(const Params& p, int b, int c, int hh, uint4& v0, uint4& v1, uint4& v2, uint4& v3, uint4& v4) {
  const int tid = opaque_tid();
  const bfu* proj = (const bfu*)(p.ws + WS_PROJ);
  const int row0 = b * SEQ + c * 64;
#define PGL(i, vi) do { const int id = (i) * NT + tid; vi = make_uint4(0u, 0u, 0u, 0u); \
    if (id < 2144) { const int row = id >> 5, ch = id & 31; \
      const int col = ch < 8 ? (C_GQ + hh * 64 + ch * 8) : (ch < 16 ? (C_GK + hh * 64 + (ch - 8) * 8) : (C_GV + hh * 128 + (ch - 16) * 8)); \
      if (c > 0 || row >= 3) vi = *(const uint4*)(proj + (size_t)(row0 + row - 3) * NP + col); } \
    else if (id < 2272) { const int id2 = id - 2144; vi = *(const uint4*)(proj + (size_t)(row0 + (id2 >> 1)) * NP + C_GLR + (id2 & 1) * 8); } } while (0)
  PGL(0, v0); PGL(1, v1); PGL(2, v2); PGL(3, v3); PGL(4, v4);
#undef PGL
}
DI void prep_gla_item(const Params& p, char* lds, int l, int b, int c, int hh, const uint4& v0, const uint4& v1, const uint4& v2, const uint4& v3, const uint4& v4, int nb, int nc, int nh, bool has_next,
                      uint4& n0, uint4& n1, uint4& n2, uint4& n3, uint4& n4) {
  const int tid = opaque_tid(), lane = tid & 63, r = lane & 31, h = lane >> 5;
  const int wave = __builtin_amdgcn_readfirstlane(tid >> 6);
  char* X = lds;
  char* G = lds + 35376;
  float* kf = (float*)(lds + 37424);
  char* vT = lds + 54832;
  char* kdT = lds + 71216;
  float* tot = (float*)(lds + 79408);
  char* Qs = lds + 81456;
  const bfu* proj = (const bfu*)(p.ws + WS_PROJ);
  bfu* qs = (bfu*)(p.ws + WS_QS); bfu* ub = (bfu*)(p.ws + WS_U); float* ab = (float*)(p.ws + WS_A);
  const int row0 = b * SEQ + c * 64;
  {
#define PGS(i, vi) do { const int id = (i) * NT + tid; if (id < 2144) *(uint4*)(X + (id >> 5) * 528 + (id & 31) * 16) = vi; else if (id < 2272) *(uint4*)(G + (id - 2144) * 16) = vi; } while (0)
    PGS(0, v0); PGS(1, v1); PGS(2, v2); PGS(3, v3); PGS(4, v4);
#undef PGS
  }
  if (has_next) prep_gla_load(p, nb, nc, nh, n0, n1, n2, n3, n4);
  __syncthreads();
  {
    const int j = tid & 255, half = tid >> 8;
    const int col = j < 64 ? (C_GQ + hh * 64 + j) : (j < 128 ? (C_GK + hh * 64 + (j - 64)) : (C_GV + hh * 128 + (j - 128)));
    const float* cw = p.conv_w + (size_t)l * 4 * 1024 + col;
    const float w0 = cw[0], w1 = cw[1024], w2 = cw[2048], w3 = cw[3072];
    const int t0 = half * 32;
    const char* xs = X + t0 * 528 + j * 2;
    float x0 = bf2f(*(const bfu*)(xs)), x1 = bf2f(*(const bfu*)(xs + 528)), x2 = bf2f(*(const bfu*)(xs + 1056));
    float y[32];
#pragma unroll
    for (int tt = 0; tt < 32; ++tt) {
      const float xt = bf2f(*(const bfu*)(xs + (tt + 3) * 528));
      y[tt] = silu_f(w0 * x0 + w1 * x1 + w2 * x2 + w3 * xt);
      x0 = x1; x1 = x2; x2 = xt;
    }
    const int role = __builtin_amdgcn_readfirstlane(j >> 6);
    if (role == 0) {
#pragma unroll
      for (int tt = 0; tt < 32; ++tt) *(bfu*)(Qs + (t0 + tt) * 128 + j * 2) = f2bf(y[tt] * 0.125f);
    } else if (role == 1) {
      float* kr = kf + (j - 64) * 68 + t0;
#pragma unroll
      for (int q4 = 0; q4 < 8; ++q4) { float4 o; o.x = y[4 * q4]; o.y = y[4 * q4 + 1]; o.z = y[4 * q4 + 2]; o.w = y[4 * q4 + 3]; *(float4*)(kr + 4 * q4) = o; }
    } else {
      const int dv = j - 128;
#pragma unroll
      for (int cc = 0; cc < 4; ++cc) {
        uint4 o; o.x = cvtpk(y[8 * cc], y[8 * cc + 1]); o.y = cvtpk(y[8 * cc + 2], y[8 * cc + 3]); o.z = cvtpk(y[8 * cc + 4], y[8 * cc + 5]); o.w = cvtpk(y[8 * cc + 6], y[8 * cc + 7]);
        *(uint4*)(vT + dv * 128 + ((((t0 >> 3) + cc) ^ ((dv >> 1) & 7)) << 4)) = o;
      }
    }
  }
  __syncthreads();
  {
    const int dk = tid & 63, tg = wave;
    float wg[16];
#pragma unroll
    for (int q = 0; q < 16; ++q) wg[q] = p.w_gk[(size_t)(l * 16 + q) * 256 + hh * 64 + dk];
    const float bias = p.b_gk[l * 256 + hh * 64 + dk];
    float cs[8]; float cum = 0.f;
#pragma unroll
    for (int i = 0; i < 8; ++i) {
      const int t = tg * 8 + i;
      const uint4* gp = (const uint4*)(G + t * 32);
      const uint4 g0 = gp[0], g1 = gp[1];
      const unsigned gw[8] = {g0.x, g0.y, g0.z, g0.w, g1.x, g1.y, g1.z, g1.w};
      float z = bias;
#pragma unroll
      for (int q = 0; q < 8; ++q) { z += bf2f(gw[q] & 0xffffu) * wg[2 * q]; z += __uint_as_float(gw[q] & 0xffff0000u) * wg[2 * q + 1]; }
      const float ls = fminf(z, 0.f) - __logf(1.f + __expf(-fabsf(z)));
      cum += ls * (1.f / 16.f);
      cs[i] = cum;
    }
    tot[tg * 64 + dk] = cum;
    __syncthreads();
    float off = 0.f, total = 0.f;
#pragma unroll
    for (int g = 0; g < 8; ++g) { const float tv = tot[g * 64 + dk]; total += tv; if (g < tg) off += tv; }
    float kd[8];
    {
      const float4 ka = *(const float4*)(kf + dk * 68 + tg * 8), kb2 = *(const float4*)(kf + dk * 68 + tg * 8 + 4);
      const float kv[8] = {ka.x, ka.y, ka.z, ka.w, kb2.x, kb2.y, kb2.z, kb2.w};
#pragma unroll
      for (int i = 0; i < 8; ++i) kd[i] = kv[i] * __expf(total - (off + cs[i]));
    }
    {
      const int t = tid >> 3, c = tid & 7;
      *(uint4*)(qs + (size_t)(row0 + t) * 256 + hh * 64 + c * 8) = *(const uint4*)(Qs + t * 128 + c * 16);
    }
    uint4 o; o.x = cvtpk(kd[0], kd[1]); o.y = cvtpk(kd[2], kd[3]); o.z = cvtpk(kd[4], kd[5]); o.w = cvtpk(kd[6], kd[7]);
    *(uint4*)(kdT + dk * 128 + ((tg ^ ((dk >> 1) & 7)) << 4)) = o;
    if (tg == 0) ab[(size_t)(b * NCH + c) * 256 + hh * 64 + dk] = __expf(total);
  }
  __syncthreads();
  {
    const int dvb = wave >> 1, dkb = wave & 1;
    f32x16 acc;
#pragma unroll
    for (int e = 0; e < 16; ++e) acc[e] = 0.f;
    const int swz = (r >> 1) & 7;
#pragma unroll
    for (int s = 0; s < 4; ++s) {
      const unsigned co = (unsigned)(((s * 2 + h) ^ swz) << 4);
      const bf16x8 a = *(const bf16x8*)(vT + (dvb * 32 + r) * 128 + co);
      const bf16x8 bb = *(const bf16x8*)(kdT + (dkb * 32 + r) * 128 + co);
      acc = MFMA32(a, bb, acc);
    }
    bfu* up = ub + (size_t)((b * NCH + c) * 4 + hh) * 8192 + dkb * 32 + r;
#pragma unroll
    for (int e = 0; e < 16; ++e) up[(dvb * 32 + crow(e, h)) * 64] = f2bf(acc[e]);
  }
  __syncthreads();
}

DI void phase_prep(const Params& p, char* lds, int l) {
  constexpr int NIT = BATCH * NCH * 4;
  uint4 a0, a1, a2, a3, a4, b0, b1, b2, b3, b4;
  int it = blockIdx.x;
  if (it < NIT) prep_gla_load(p, (it & 511) >> 8, it & 255, it >> 9, a0, a1, a2, a3, a4);
  for (; it < NIT; it += gridDim.x) {
    const int ty = it >> 9, ch = it & 511, b = ch >> 8, c = ch & 255;
    const int nx = it + gridDim.x; const bool hn = nx < NIT;
    prep_gla_item(p, lds, l, b, c, ty, a0, a1, a2, a3, a4, (nx & 511) >> 8, nx & 255, nx >> 9, hn, b0, b1, b2, b3, b4);
    a0 = b0; a1 = b1; a2 = b2; a3 = b3; a4 = b4;
  }
}

#define XB_TMO      128
#define XB_XCNT(j)  (256  + 64 * (j))
#define XB_XSUB(j)  (1280 + 64 * (j))
#define XB_XGEN(j)  (2304 + 64 * (j))
#define XB_TOP      3328
#define XB_TOPGEN   3392
#define XCD_BAR_WORDS 3456
#define XB_SPIN_CAP (1u << 18)
DI unsigned xb_ld(unsigned* p) { return __hip_atomic_load(p, __ATOMIC_RELAXED, __HIP_MEMORY_SCOPE_AGENT); }
DI unsigned xb_add(unsigned* p, unsigned v) { return __hip_atomic_fetch_add(p, v, __ATOMIC_RELAXED, __HIP_MEMORY_SCOPE_AGENT); }
DI unsigned xb_xcc_id() { return (unsigned)__builtin_amdgcn_s_getreg((3 << 11) | 20) & 0xFu; }
#define XB_SPIN(cond, bar) do { unsigned _sp = 0; while (cond) { __builtin_amdgcn_s_sleep(1); \
    if ((++_sp & 255u) == 0u) { if (xb_ld(&(bar)[XB_TMO])) break; if (_sp > XB_SPIN_CAP) { atomicAdd(&(bar)[XB_TMO], 1u); break; } } } } while (0)
struct XcdBarrier { unsigned* bar; unsigned x; };
DI XcdBarrier xcd_barrier_post(unsigned* bar) {
  XcdBarrier b; b.bar = bar; b.x = xb_xcc_id();
  if (threadIdx.x == 0) (void)xb_add(&bar[XB_XCNT(b.x)], 1u);
  return b;
}
DI void xcd_barrier_complete(unsigned* bar, unsigned x, unsigned& nloc, unsigned& nx) {
  const unsigned G = gridDim.x * gridDim.y * gridDim.z;
  unsigned sum, cnt, mine, sp = 0u;
  for (;;) {
    sum = 0u; cnt = 0u; mine = 0u;
#pragma unroll
    for (unsigned j = 0; j < 16; ++j) { const unsigned c = xb_ld(&bar[XB_XCNT(j)]); sum += c; cnt += (c > 0u) ? 1u : 0u; mine = (j == x) ? c : mine; }
    if (sum == G) break;
    __builtin_amdgcn_s_sleep(1);
    if ((++sp & 255u) == 0u) { if (xb_ld(&bar[XB_TMO])) break; if (sp > XB_SPIN_CAP) { atomicAdd(&bar[XB_TMO], 1u); break; } }
  }
  nloc = mine > 0u ? mine : 1u; nx = cnt > 0u ? cnt : 1u;
}
DI void xcd_barrier(const XcdBarrier& b, volatile unsigned* st) {
  asm volatile("s_waitcnt vmcnt(0)" ::: "memory");
  __syncthreads();
  if (threadIdx.x == 0) {
    unsigned* bar = b.bar;
    const unsigned bx = xb_xcc_id();
    __builtin_amdgcn_s_waitcnt(0);
    unsigned nloc = st[0], nx = st[1];
    if (nloc == 0u) { xcd_barrier_complete(bar, bx, nloc, nx); st[0] = nloc; st[1] = nx; }
    const unsigned old = xb_add(&bar[XB_XSUB(bx)], 1u);
    const unsigned gen = old / nloc;
    if (old + 1u == (gen + 1u) * nloc) {
      __builtin_amdgcn_fence(__ATOMIC_RELEASE, "agent");
      asm volatile("s_waitcnt vmcnt(0)" ::: "memory");
      const unsigned og = xb_add(&bar[XB_TOP], 1u);
      const unsigned tg = og / nx;
      if (og + 1u == (tg + 1u) * nx) xb_add(&bar[XB_TOPGEN], 1u);
      else XB_SPIN(xb_ld(&bar[XB_TOPGEN]) == tg, bar);
      __builtin_amdgcn_fence(__ATOMIC_ACQUIRE, "agent");
      xb_add(&bar[XB_XGEN(bx)], 1u);
      asm volatile("s_waitcnt vmcnt(0)" ::: "memory");
    } else {
      XB_SPIN(xb_ld(&bar[XB_XGEN(bx)]) == gen, bar);
      __builtin_amdgcn_fence(__ATOMIC_ACQUIRE, "agent");
      asm volatile("s_waitcnt vmcnt(0)" ::: "memory");
    }
  }
  __syncthreads();
}

DI void phase_ogla(const Params& p, char* lds, int l) {
  const int tid = opaque_tid(), lane = tid & 63, r = lane & 31, h = lane >> 5;
  const int wave = __builtin_amdgcn_readfirstlane(tid >> 6), hh = wave >> 1, tb = wave & 1;
  const bfu* qs = (const bfu*)(p.ws + WS_QS); const bfu* ub = (const bfu*)(p.ws + WS_U);
  const bfu* proj = (const bfu*)(p.ws + WS_PROJ); bfu* mix = (bfu*)(p.ws + WS_H);
  const float* gg = p.gla_g + l * 128;
  for (int it = blockIdx.x; it < BATCH * NCH; it += gridDim.x) {
    const int b = it >> 8, c = it & 255;
    const size_t row = (size_t)b * SEQ + c * 64 + tb * 32 + r;
    bf16x8 qf[4];
#pragma unroll
    for (int ks = 0; ks < 4; ++ks) qf[ks] = *(const bf16x8*)(qs + row * 256 + hh * 64 + ks * 16 + h * 8);
    uint2 zq[16];
    {
      const size_t rowz = (size_t)b * SEQ + c * 64 + tb * 32;
#pragma unroll
      for (int it2 = 0; it2 < 16; ++it2) { const int id = it2 * 64 + lane; zq[it2] = *(const uint2*)(proj + (rowz + (id >> 5)) * NP + C_GZ + hh * 128 + (id & 31) * 4); }
    }
    const bfu* sp = ub + (size_t)((b * NCH + c) * 4 + hh) * 8192;
    f32x16 O[4];
#pragma unroll
    for (int d = 0; d < 4; ++d) {
#pragma unroll
      for (int e = 0; e < 16; ++e) O[d][e] = 0.f;
#pragma unroll
      for (int ks = 0; ks < 4; ++ks) {
        const bf16x8 sf = *(const bf16x8*)(sp + (d * 32 + r) * 64 + ks * 16 + h * 8);
        O[d] = MFMA32(sf, qf[ks], O[d]);
      }
    }
    float ss = 0.f;
#pragma unroll
    for (int d = 0; d < 4; ++d)
#pragma unroll
      for (int e = 0; e < 16; ++e) ss += O[d][e] * O[d][e];
    ss += __shfl_xor(ss, 32);
    const float rstd = rsqrtf(ss * (1.f / 128.f) + EPS);
    char* stg = lds + wave * 16896;
    asm volatile("s_waitcnt lgkmcnt(0)" ::: "memory");
#pragma unroll
    for (int d = 0; d < 4; ++d)
#pragma unroll
      for (int g = 0; g < 4; ++g) {
        float4 o; o.x = O[d][4 * g] * rstd; o.y = O[d][4 * g + 1] * rstd; o.z = O[d][4 * g + 2] * rstd; o.w = O[d][4 * g + 3] * rstd;
        *(float4*)(stg + r * 528 + (d * 32 + 8 * g + 4 * h) * 4) = o;
      }
    asm volatile("s_waitcnt lgkmcnt(0)" ::: "memory");
    const size_t row0 = (size_t)b * SEQ + c * 64 + tb * 32;
#pragma unroll
    for (int it2 = 0; it2 < 16; ++it2) {
      const int id = it2 * 64 + lane, rr = id >> 5, cc = id & 31;
      const float4 v = *(const float4*)(stg + rr * 528 + cc * 16);
      const uint2 zr = zq[it2];
      const float4 gv = *(const float4*)(gg + cc * 4);
      const float z0 = bf2f(zr.x & 0xffffu), z1 = __uint_as_float(zr.x & 0xffff0000u), z2 = bf2f(zr.y & 0xffffu), z3 = __uint_as_float(zr.y & 0xffff0000u);
      uint2 o;
      o.x = cvtpk(v.x * gv.x * silu_f(z0), v.y * gv.y * silu_f(z1));
      o.y = cvtpk(v.z * gv.z * silu_f(z2), v.w * gv.w * silu_f(z3));
      *(uint2*)(mix + (row0 + rr) * 1024 + hh * 128 + cc * 4) = o;
    }
  }
}

DI void scan_items(const Params& p) {
  const int tid = opaque_tid();
  bfu* ub = (bfu*)(p.ws + WS_U); const float* ab = (const float*)(p.ws + WS_A);
  if (tid < 256) {
    for (int it = blockIdx.x; it < 256; it += gridDim.x) {
      const int e = it * 256 + tid, b = e >> 15, rem = e & 32767, hh = rem >> 13, dk = rem & 63;
      bfu* up = ub + (size_t)b * NCH * 32768 + rem;
      const float* ap = ab + (size_t)b * NCH * 256 + hh * 64 + dk;
      float st = 0.f;
      for (int c0 = 0; c0 < NCH; c0 += 32) {
        bfu uv[32]; float av[32];
#pragma unroll
        for (int i = 0; i < 32; ++i) { uv[i] = up[(size_t)(c0 + i) * 32768]; av[i] = ap[(c0 + i) * 256]; }
#pragma unroll
        for (int i = 0; i < 32; ++i) { st = av[i] * st + bf2f(uv[i]); up[(size_t)(c0 + i) * 32768] = f2bf(st); }
      }
    }
  }
}

DI void attn_item(const Params& p, char* lds, int l, int bh, int jt, float lam, float outscale) {
  const int tid = opaque_tid(), lane = tid & 63, r = lane & 31, h = lane >> 5;
  const int wave = __builtin_amdgcn_readfirstlane(tid >> 6);
  const bfu* Kg = (const bfu*)(p.ws + WS_KN) + (size_t)bh * SEQ * 128;
  const bfu* Qg = (const bfu*)(p.ws + WS_QN) + (size_t)bh * SEQ * 128;
  const bfu* Vg = (const bfu*)(p.ws + WS_VT) + (size_t)bh * 128 * SEQ;
  const int nkt = 4 * jt + 4, my_last = 4 * jt + (wave >> 1);
  const int qrow = jt * 256 + wave * 32 + r;
  const int krow_l = 4 * wave + (lane >> 4), kp = lane & 15;
  const bfu* kgp = Kg + (size_t)krow_l * 128 + ((kp ^ (krow_l & 15)) * 8);
  const int vrow_l = 8 * wave + (lane >> 3), vp = lane & 7;
  const bfu* vgp = Vg + (size_t)vrow_l * SEQ + ((vp ^ ((vrow_l >> 1) & 7)) * 8);
  const unsigned lds0 = (unsigned)(uintptr_t)lds;
  const unsigned dk0 = (unsigned)__builtin_amdgcn_readfirstlane(lds0 + wave * 1024);
#define DMA_TILE(kt_, so_) do { glds16(kgp + (size_t)(kt_) * 64 * 128, dk0 + (so_)); glds16(kgp + (size_t)(kt_) * 64 * 128 + 32 * 128, dk0 + (so_) + 8192); \
    glds16(vgp + (kt_) * 64, dk0 + (so_) + 16384); glds16(vgp + (size_t)64 * SEQ + (kt_) * 64, dk0 + (so_) + 24576); } while (0)
  WAIT_BAR0();
  DMA_TILE(0, 0);
  char* q1s = lds + 65536 + tid * 16;
#pragma unroll
  for (int ks = 0; ks < 4; ++ks) {
    *(bf16x8*)(q1s + 32768 + ks * 8192) = *(const bf16x8*)(Qg + (size_t)qrow * 128 + ks * 16 + h * 8);
    *(bf16x8*)(q1s + ks * 8192) = *(const bf16x8*)(Qg + (size_t)qrow * 128 + 64 + ks * 16 + h * 8);
  }
  f32x16 O0[4], O1[4];
#pragma unroll
  for (int d = 0; d < 4; ++d)
#pragma unroll
    for (int e = 0; e < 16; ++e) { O0[d][e] = 0.f; O1[d][e] = 0.f; }
  float l0 = 0.f, l1 = 0.f;
  const int pr = pi_row(r);
  const unsigned kb = pr * 256 + (((pr & 15) ^ h) << 4);
  const unsigned vb = 16384 + r * 128 + ((((r >> 1) & 7) ^ h) << 4);
  for (int kt = 0; kt < nkt; ++kt) {
    WAIT_BAR0();
    const unsigned so = (kt & 1) * 32768;
    if (kt + 1 < nkt) DMA_TILE(kt + 1, 32768 - so);
    if (kt <= my_last) {
#define KFRAG(sub_, mp_, ks_) (*(const bf16x8*)(lds + ((kb + so + (sub_) * 8192) ^ (unsigned)((((mp_) * 8) + (ks_) * 2) << 4))))
#define VFRAG(sub_, d_, s_) (*(const bf16x8*)(lds + ((vb + so + (d_) * 4096) ^ (unsigned)(((sub_) * 4 + (s_) * 2) << 4))))
#define QFRAG(mp_, ks_) (*(const bf16x8*)(q1s + ((mp_) ? 0 : 32768) + (ks_) * 8192))
#define SOFTMAX_PACK(S_, P_, l_) do { _Pragma("unroll") for (int e = 0; e < 16; ++e) { S_[e] = __builtin_amdgcn_exp2f(S_[e]); l_ += S_[e]; } \
        _Pragma("unroll") for (int s = 0; s < 2; ++s) { u32x4 a_; _Pragma("unroll") for (int q = 0; q < 4; ++q) a_[q] = cvtpk(S_[8 * s + 2 * q], S_[8 * s + 2 * q + 1]); P_[s] = __builtin_bit_cast(bf16x8, a_); } } while (0)
      bf16x8 pa0[2], pa1[2];
      f32x16 S0, S1;
#pragma unroll
      for (int e = 0; e < 16; ++e) { S0[e] = 0.f; S1[e] = 0.f; }
#pragma unroll
      for (int ks = 0; ks < 4; ++ks) {
        S0 = MFMA32(KFRAG(0, 0, ks), QFRAG(0, ks), S0);
        S1 = MFMA32(KFRAG(0, 1, ks), QFRAG(1, ks), S1);
      }
      SOFTMAX_PACK(S0, pa0, l0);
      SOFTMAX_PACK(S1, pa1, l1);
#pragma unroll
      for (int e = 0; e < 16; ++e) { S0[e] = 0.f; S1[e] = 0.f; }
#pragma unroll
      for (int ks = 0; ks < 4; ++ks) {
        S0 = MFMA32(KFRAG(1, 0, ks), QFRAG(0, ks), S0);
        S1 = MFMA32(KFRAG(1, 1, ks), QFRAG(1, ks), S1);
#pragma unroll
        for (int dd = 0; dd < 2; ++dd) {
          const int d = (ks & 1) * 2 + dd, s = ks >> 1;
          const bf16x8 vf = VFRAG(0, d, s);
          O0[d] = MFMA32(vf, pa0[s], O0[d]);
          O1[d] = MFMA32(vf, pa1[s], O1[d]);
        }
      }
      bf16x8 pc0[2], pc1[2];
      SOFTMAX_PACK(S0, pc0, l0);
      SOFTMAX_PACK(S1, pc1, l1);
#pragma unroll
      for (int s = 0; s < 2; ++s) {
#pragma unroll
        for (int d = 0; d < 4; ++d) {
          const bf16x8 vf = VFRAG(1, d, s);
          O0[d] = MFMA32(vf, pc0[s], O0[d]);
          O1[d] = MFMA32(vf, pc1[s], O1[d]);
        }
      }
#undef KFRAG
#undef VFRAG
#undef QFRAG
#undef SOFTMAX_PACK
    }
  }
#undef DMA_TILE
  l0 += __shfl_xor(l0, 32); l1 += __shfl_xor(l1, 32);
  const float i0 = 1.f / l0, i1 = -lam / l1;
  float ss = 0.f;
#pragma unroll
  for (int d = 0; d < 4; ++d)
#pragma unroll
    for (int e = 0; e < 16; ++e) { const float o = O0[d][e] * i0 + O1[d][e] * i1; O0[d][e] = o; ss += o * o; }
  ss += __shfl_xor(ss, 32);
  const float rstd = rsqrtf(ss * (1.f / 128.f) + EPS) * outscale;
  const int b = bh >> 2, hh = bh & 3;
  const size_t row = (size_t)b * SEQ + qrow;
  const bfu* zp = (const bfu*)(p.ws + WS_PROJ) + row * NP + C_DZ + hh * 128;
  bfu* mp = (bfu*)(p.ws + WS_H) + row * 1024 + 512 + hh * 128;
  const float* gd = p.diff_g + l * 128;
#pragma unroll
  for (int d = 0; d < 4; ++d)
#pragma unroll
    for (int g = 0; g < 4; ++g) {
      const int dv = d * 32 + 8 * g + 4 * h;
      const uint2 zr = *(const uint2*)(zp + dv);
      const float4 gv = *(const float4*)(gd + dv);
      const float z0 = bf2f(zr.x & 0xffffu), z1 = __uint_as_float(zr.x & 0xffff0000u), z2 = bf2f(zr.y & 0xffffu), z3 = __uint_as_float(zr.y & 0xffff0000u);
      uint2 o;
      o.x = cvtpk(O0[d][4 * g] * rstd * gv.x * silu_f(z0), O0[d][4 * g + 1] * rstd * gv.y * silu_f(z1));
      o.y = cvtpk(O0[d][4 * g + 2] * rstd * gv.z * silu_f(z2), O0[d][4 * g + 3] * rstd * gv.w * silu_f(z3));
      *(uint2*)(mp + dv) = o;
    }
}

DI void phase_attn(const Params& p, char* lds, int l) {
  scan_items(p);
  const float lam = ((const float*)(p.ws + WS_LAM))[l];
  const float outscale = 1.f - p.lam_init[l];
  unsigned* scnt = (unsigned*)(p.ws + WS_BAR) + 3584;
  asm volatile("s_waitcnt vmcnt(0)" ::: "memory");
  __syncthreads();
  if (threadIdx.x == 0) {
    __builtin_amdgcn_fence(__ATOMIC_RELEASE, "agent");
    asm volatile("s_waitcnt vmcnt(0)" ::: "memory");
    (void)xb_add(scnt, 1u);
  }
  if (__builtin_amdgcn_readfirstlane(threadIdx.x) >= 256) __builtin_amdgcn_s_setprio(1);
  for (int pr = blockIdx.x; pr < 256; pr += gridDim.x) {
    const int bh = pr & 7, jj = pr >> 3;
#pragma unroll 1
    for (int rep = 0; rep < 2; ++rep) attn_item(p, lds, l, bh, rep ? jj : 63 - jj, lam, outscale);
  }
  __builtin_amdgcn_s_setprio(0);
  if (threadIdx.x == 0) {
    const unsigned target = gridDim.x * (unsigned)(l + 1);
    unsigned sp = 0;
    while (xb_ld(scnt) < target) { __builtin_amdgcn_s_sleep(1); if (++sp > (1u << 22)) break; }
    __builtin_amdgcn_fence(__ATOMIC_ACQUIRE, "agent");
    asm volatile("s_waitcnt vmcnt(0)" ::: "memory");
  }
  __syncthreads();
  phase_ogla(p, lds, l);
}

__global__ void __launch_bounds__(NT) fwd_megakernel(Params p) {
  extern __shared__ __attribute__((aligned(16))) char lds[];
  cg::grid_group grid = cg::this_grid();
  volatile unsigned* xst = (volatile unsigned*)(lds + LDS_BYTES);
  if (threadIdx.x == 0) { xst[0] = 0u; xst[1] = 0u; }
  __syncthreads();
  const XcdBarrier xbar = xcd_barrier_post((unsigned*)(p.ws + WS_BAR));
#define GBAR() xcd_barrier(xbar, (volatile unsigned*)(lds + LDS_BYTES))
  p0_prologue(p, lds);
  grid.sync();
  {
    const int wv = __builtin_amdgcn_readfirstlane(threadIdx.x >> 6);
#pragma unroll 1
    for (int step = 0; step < 2; ++step) { if ((step ^ wv) & 1) p0_tiles(p, lds); else phase_norm(p, 0, p.x); }
  }
  GBAR();
#pragma unroll 1
  for (int l = 0; l < DEPTH; ++l) {
    const float* xin = (l == 0) ? p.x : p.out;
    if (l > 0) { phase_norm(p, l, xin); GBAR(); }
    gemm_phase<0>(p, lds, (const bfu*)(p.ws + WS_H), (const bfu*)(p.ws + WS_WINT) + (size_t)l * NP * 1024, 14, l, nullptr);
    GBAR();
    phase_prep(p, lds, l);
    GBAR();
    phase_attn(p, lds, l);
    GBAR();
    gemm_phase<1>(p, lds, (const bfu*)(p.ws + WS_H), (const bfu*)(p.ws + WS_WOUTT) + (size_t)l * 1024 * 1024, 4, l, xin);
    if (l + 1 < DEPTH) GBAR();
  }
#undef GBAR
}

#ifndef MK_SPLIT
#define MK_SPLIT 0
#endif

extern "C" void kernel_launch(void* const* d_in, const int* in_sizes, int n_in, void* d_out, int out_size, void* d_ws, size_t ws_size, hipStream_t stream) {
  static int grid_blocks = 0;
  if (!grid_blocks) {
    if (ws_size < WS_END) { fprintf(stderr, "kernel_launch: workspace too small: %zu < %zu\n", ws_size, (size_t)WS_END); grid_blocks = -1; return; }
    int dev = 0, cus = 0, per_cu = 0;
    hipGetDevice(&dev);
    hipDeviceGetAttribute(&cus, hipDeviceAttributeMultiprocessorCount, dev);
    hipFuncSetAttribute((const void*)fwd_megakernel, hipFuncAttributeMaxDynamicSharedMemorySize, LDS_BYTES + 16);
    hipOccupancyMaxActiveBlocksPerMultiprocessor(&per_cu, (const void*)fwd_megakernel, NT, LDS_BYTES + 16);
    if (per_cu < 1) per_cu = 1;
    if (per_cu > 1) per_cu = 1;
    grid_blocks = cus * per_cu;
  }
  if (grid_blocks < 0) return;
  Params p{};
  p.x = (const float*)d_in[0]; p.c = (const float*)d_in[1]; p.w_ada = (const float*)d_in[2]; p.b_ada = (const float*)d_in[3];
  p.norm_g = (const float*)d_in[4]; p.w_in = (const float*)d_in[5]; p.conv_w = (const float*)d_in[6]; p.w_gk = (const float*)d_in[7];
  p.b_gk = (const float*)d_in[8]; p.gla_g = (const float*)d_in[9]; p.qn_g = (const float*)d_in[10]; p.kn_g = (const float*)d_in[11];
  p.lq1 = (const float*)d_in[12]; p.lk1 = (const float*)d_in[13]; p.lq2 = (const float*)d_in[14]; p.lk2 = (const float*)d_in[15];
  p.diff_g = (const float*)d_in[16]; p.w_out = (const float*)d_in[17];
  p.out = (float*)d_out; p.ws = (unsigned char*)d_ws;
  const double li[4] = {0.8 - 0.6 * 1.0, 0.8 - 0.6 * 0.7408182206817179, 0.8 - 0.6 * 0.5488116360940264, 0.8 - 0.6 * 0.4065696597405991};
  for (int l = 0; l < 4; ++l) p.lam_init[l] = (float)li[l];
  hipMemsetAsync((char*)d_ws + WS_BAR, 0, 16384, stream);
  constexpr int NPH = 2 + 6 * DEPTH;
  void* args[] = {&p};
  hipError_t e = hipLaunchCooperativeKernel((void*)fwd_megakernel, dim3(grid_blocks), dim3(NT), args, LDS_BYTES + 16, stream);
  if (e != hipSuccess) fprintf(stderr, "cooperative launch failed: %s (grid %d)\n", hipGetErrorString(e), grid_blocks);
}
```

```cpp
#include <hip/hip_runtime.h>
#include <hip/hip_bf16.h>
#include <hip/hip_cooperative_groups.h>
#include <cstdio>
#include <cstdint>
namespace cg = cooperative_groups;

#define DI __device__ __forceinline__
typedef unsigned short bfu;
using bf16x8 = __attribute__((ext_vector_type(8))) short;
using f32x16 = __attribute__((ext_vector_type(16))) float;
using u32x4  = __attribute__((ext_vector_type(4))) unsigned;
#define MFMA32(a, b, c) __builtin_amdgcn_mfma_f32_32x32x16_bf16((a), (b), (c), 0, 0, 0)

constexpr int D = 1024, BATCH = 2, SEQ = 16384, DEPTH = 4, T = BATCH * SEQ;
constexpr int NCH = SEQ / 64;
constexpr int INW = 3600, NP = 3840;
constexpr int C_GQ = 0, C_GK = 256, C_GV = 512, C_GZ = 1024, C_DQ = 1536, C_DK = 2048, C_DV = 2560, C_DZ = 3072, C_GLR = 3584;
constexpr float EPS = 1e-6f;
constexpr float LOG2E = 1.4426950408889634f;
constexpr int NT = 512;
constexpr int LDS_BYTES = 139264;

constexpr size_t WS_WINT = 0;
constexpr size_t WS_WOUTT = WS_WINT + (size_t)DEPTH * NP * D * 2;
constexpr size_t WS_MODP = WS_WOUTT + (size_t)DEPTH * D * D * 2;
constexpr size_t WS_MOD = WS_MODP + (size_t)DEPTH * 8 * 2 * 3072 * 4;
constexpr size_t WS_LAM = WS_MOD + (size_t)DEPTH * 2 * 3072 * 4;
constexpr size_t WS_H = WS_LAM + 256;
constexpr size_t WS_PROJ = WS_H + (size_t)T * D * 2;
constexpr size_t WS_U = WS_PROJ + (size_t)T * NP * 2;
constexpr size_t WS_A = WS_U + (size_t)BATCH * NCH * 4 * 8192 * 2;
constexpr size_t WS_QS = WS_A + (size_t)BATCH * NCH * 256 * 4;
constexpr size_t WS_QN = WS_QS + (size_t)T * 256 * 2;
constexpr size_t WS_KN = WS_QN + (size_t)T * 512 * 2;
constexpr size_t WS_VT = WS_KN + (size_t)T * 512 * 2;
constexpr size_t WS_BAR = WS_VT + (size_t)T * 512 * 2;
constexpr size_t WS_END = WS_BAR + 16384;

struct Params {
  const float *x, *c, *w_ada, *b_ada, *norm_g, *w_in, *conv_w, *w_gk, *b_gk, *gla_g, *qn_g, *kn_g, *lq1, *lk1, *lq2, *lk2, *diff_g, *w_out;
  float* out; unsigned char* ws;
  float lam_init[4];
  int ph_lo, ph_hi;
};

DI int opaque_tid() { int t = threadIdx.x; asm volatile("" : "+v"(t)); return t; }
DI float bf2f(unsigned u) { return __uint_as_float(u << 16); }
typedef __bf16 bf16x2_t __attribute__((ext_vector_type(2)));
typedef float f32x2_t __attribute__((ext_vector_type(2)));
DI unsigned cvtpk(float lo, float hi) { f32x2_t v = {lo, hi}; bf16x2_t r = __builtin_convertvector(v, bf16x2_t); return __builtin_bit_cast(unsigned, r); }
DI bfu f2bf(float x) { return (bfu)(cvtpk(x, 0.f) & 0xffffu); }
DI float silu_f(float x) { return x * __builtin_amdgcn_rcpf(1.f + __expf(-x)); }
DI int crow(int reg, int h) { return (reg & 3) + 8 * (reg >> 2) + 4 * h; }
DI int pi_row(int r) { return (r & ~12) | ((r & 4) << 1) | ((r & 8) >> 1); }
DI float wave_sum(float v) {
#pragma unroll
  for (int o = 32; o >= 1; o >>= 1) v += __shfl_xor(v, o);
  return v;
}

DI void glds16(const void* g, unsigned lds_base) {
  unsigned sv; asm volatile("s_mov_b32 %0, m0\n\ts_mov_b32 m0, %2\n\ts_nop 0\n\tglobal_load_lds_dwordx4 %1, off\n\ts_mov_b32 m0, %0" : "=&s"(sv) : "v"(g), "s"(lds_base) : "memory"); }
#define WAIT_BAR0() asm volatile("s_waitcnt vmcnt(0) lgkmcnt(0)\n\ts_barrier" ::: "memory")


DI void p0_prologue(const Params& p, char* lds) {
  const int tid = opaque_tid(), lane = tid & 63;
  const int wave = __builtin_amdgcn_readfirstlane(tid >> 6);
  bfu* WinT = (bfu*)(p.ws + WS_WINT); bfu* WoutT = (bfu*)(p.ws + WS_WOUTT);
  float* lamv = (float*)(p.ws + WS_LAM);
  constexpr int N_MOD = DEPTH * 48;
  {
    float* red = (float*)lds;
    for (int it = blockIdx.x; it < N_MOD + 1; it += gridDim.x) {
      if (it < N_MOD) {
        const int l = it / 48, jb = it % 48;
        const int j = lane, ks = wave;
        float a0 = 0.f, a1 = 0.f;
        const float* wp = p.w_ada + (size_t)(l * 1024 + ks * 128) * 3072 + jb * 64 + j;
        const float* cp = p.c + ks * 128;
#pragma unroll 32
        for (int k = 0; k < 128; ++k) { const float w = wp[(size_t)k * 3072]; a0 += silu_f(cp[k]) * w; a1 += silu_f(cp[1024 + k]) * w; }
        red[(ks * 2 + 0) * 64 + j] = a0; red[(ks * 2 + 1) * 64 + j] = a1;
        __syncthreads();
        if (tid < 128) {
          const int b = tid >> 6;
          float acc = p.b_ada[l * 3072 + jb * 64 + j];
#pragma unroll
          for (int q = 0; q < 8; ++q) acc += red[(q * 2 + b) * 64 + j];
          ((float*)(p.ws + WS_MOD))[(l * 2 + b) * 3072 + jb * 64 + j] = acc;
        }
        __syncthreads();
      } else if (tid < 64) {
        for (int l = 0; l < DEPTH; ++l) {
          float s1 = p.lq1[l * 64 + tid] * p.lk1[l * 64 + tid], s2 = p.lq2[l * 64 + tid] * p.lk2[l * 64 + tid];
          s1 = wave_sum(s1); s2 = wave_sum(s2);
          if (tid == 0) lamv[l] = expf(s1) - expf(s2) + p.lam_init[l];
        }
      }
    }
  }
}

DI void p0_tiles(const Params& p, char* lds) {
  const int tid = opaque_tid(), lane = tid & 63;
  const int wave = __builtin_amdgcn_readfirstlane(tid >> 6);
  bfu* WinT = (bfu*)(p.ws + WS_WINT); bfu* WoutT = (bfu*)(p.ws + WS_WOUTT);
  {
    constexpr int N_IN = DEPTH * 16 * 57, N_OUT = DEPTH * 16 * 16;
    float* tile = (float*)(lds + wave * 16640);
    for (int it = blockIdx.x * 8 + wave; it < N_IN + N_OUT; it += gridDim.x * 8) {
      const bool isin = it < N_IN;
      int l, kt, nt;
      if (isin) { l = it / (16 * 57); int rr = it % (16 * 57); nt = rr / 16; kt = rr % 16; }
      else { int r2 = it - N_IN; l = r2 / 256; int rr = r2 % 256; nt = rr / 16; kt = rr % 16; }
      const int k0 = kt * 64, n0 = nt * 64;
      const int np = n0 + lane;
      const int on = np < 1024 ? np : (np < 3584 ? np + 16 : (np < 3600 ? np - 3584 + 1024 : -1));
      const float* srcp = isin ? (p.w_in + (size_t)(l * 1024 + k0) * INW + (on >= 0 ? on : 0)) : (p.w_out + (size_t)(l * 1024 + k0) * 1024 + n0 + lane);
      const size_t pitch = isin ? INW : 1024;
      const bool live = !isin || on >= 0;
      float v[64];
#pragma unroll
      for (int kk = 0; kk < 64; ++kk) v[kk] = live ? srcp[(size_t)kk * pitch] : 0.f;
      asm volatile("s_waitcnt lgkmcnt(0)" ::: "memory");
#pragma unroll
      for (int kk = 0; kk < 64; ++kk) tile[kk * 65 + lane] = v[kk];
      asm volatile("s_waitcnt lgkmcnt(0)" ::: "memory");
#pragma unroll
      for (int q = 0; q < 8; ++q) {
        const int nn = q * 8 + (lane >> 3), kc = lane & 7;
        const float* tp = tile + (kc * 8) * 65 + nn;
        uint4 o; o.x = cvtpk(tp[0], tp[65]); o.y = cvtpk(tp[130], tp[195]); o.z = cvtpk(tp[260], tp[325]); o.w = cvtpk(tp[390], tp[455]);
        bfu* dst = isin ? (WinT + ((size_t)l * NP + n0 + nn) * 1024 + k0 + kc * 8) : (WoutT + ((size_t)l * 1024 + n0 + nn) * 1024 + k0 + kc * 8);
        *(uint4*)dst = o;
      }
    }
  }
}

DI void phase_norm(const Params& p, int l, const float* xin) {
  const int tid = opaque_tid(), lane = tid & 63, wave = tid >> 6;
  const float* g = p.norm_g + l * 1024; const float* md = (const float*)(p.ws + WS_MOD) + l * 6144;
  bfu* hb = (bfu*)(p.ws + WS_H);
  for (int r0 = (blockIdx.x * 8 + wave) * 16; r0 < T; r0 += gridDim.x * 8 * 16) {
    const int b = r0 >> 14;
    float4 ga[4], sh[4];
#pragma unroll
    for (int i = 0; i < 4; ++i) {
      const int k = (lane + 64 * i) * 4;
      const float4 g4 = *(const float4*)(g + k), sc = *(const float4*)(md + b * 3072 + 1024 + k);
      sh[i] = *(const float4*)(md + b * 3072 + k);
      ga[i].x = g4.x * (1.f + sc.x); ga[i].y = g4.y * (1.f + sc.y); ga[i].z = g4.z * (1.f + sc.z); ga[i].w = g4.w * (1.f + sc.w);
    }
#pragma unroll 1
    for (int rg = 0; rg < 16; rg += 4) {
      float4 v[4][4];
#pragma unroll
      for (int q = 0; q < 4; ++q) {
        const float4* xr = (const float4*)(xin + (size_t)(r0 + rg + q) * 1024);
#pragma unroll
        for (int i = 0; i < 4; ++i) v[q][i] = xr[lane + 64 * i];
      }
#pragma unroll
      for (int q = 0; q < 4; ++q) {
        float ss = 0.f;
#pragma unroll
        for (int i = 0; i < 4; ++i) ss += v[q][i].x * v[q][i].x + v[q][i].y * v[q][i].y + v[q][i].z * v[q][i].z + v[q][i].w * v[q][i].w;
        ss = wave_sum(ss);
        const float rstd = rsqrtf(ss * (1.f / 1024.f) + EPS);
#pragma unroll
        for (int i = 0; i < 4; ++i) {
          const int k = (lane + 64 * i) * 4;
          const float o0 = v[q][i].x * rstd * ga[i].x + sh[i].x, o1 = v[q][i].y * rstd * ga[i].y + sh[i].y;
          const float o2 = v[q][i].z * rstd * ga[i].z + sh[i].z, o3 = v[q][i].w * rstd * ga[i].w + sh[i].w;
          uint2 o; o.x = cvtpk(o0, o1); o.y = cvtpk(o2, o3);
          *(uint2*)(hb + (size_t)(r0 + rg + q) * 1024 + k) = o;
        }
      }
    }
  }
}

DI void tile_map(int idx, int ntn, int& tm, int& tn) {
  const int xcd = idx & 7, li = idx >> 3, g4 = 4 * ntn, g = li / g4, rem = li - g * g4;
  tn = rem >> 2; tm = xcd * 16 + g * 4 + (rem & 3);
}
template <int EPI>
DI void gemm_phase(const Params& p, char* lds, const bfu* __restrict__ A, const bfu* __restrict__ BT, int ntn, int l, const float* xin) {
  const int tid = opaque_tid(), lane = tid & 63, r = lane & 31, h = lane >> 5;
  const int wave = __builtin_amdgcn_readfirstlane(tid >> 6), wm = wave >> 1, wn = wave & 1;
  const int drow = 8 * wave + (lane >> 3);
  const int dsrc = drow * 1024 + (((lane & 7) ^ ((drow >> 1) & 7)) << 3);
  const unsigned lds0 = (unsigned)(uintptr_t)lds;
  const unsigned dd0 = (unsigned)__builtin_amdgcn_readfirstlane(lds0 + wave * 1024);
  const int swz = (r >> 1) & 7;
  const int ntiles = (T / 256) * ntn;
#define DMA_SLAB(Ap, Bp, kk, so) do { const bfu* a_ = (Ap) + dsrc + (kk) * 64; const bfu* b_ = (Bp) + dsrc + (kk) * 64; \
      _Pragma("unroll") for (int q_ = 0; q_ < 4; ++q_) { glds16(a_ + q_ * 64 * 1024, dd0 + (so) + q_ * 8192); glds16(b_ + q_ * 64 * 1024, dd0 + (so) + 32768 + q_ * 8192); } } while (0)
#define SBAR() __builtin_amdgcn_sched_barrier(0)
#define WSYNC() asm volatile("s_waitcnt lgkmcnt(0)" ::: "memory")
#define DMA_PIECE(Ap, Bp, kk, so, pz) glds16((((pz) < 4) ? (Ap) : (Bp)) + dsrc + (kk) * 64 + ((pz) & 3) * 64 * 1024, dd0 + (so) + ((pz) < 4 ? 0 : 32768) + ((pz) & 3) * 8192)
  WAIT_BAR0();
  if ((int)blockIdx.x < ntiles) {
    int tm, tn; tile_map((int)blockIdx.x, ntn, tm, tn);
    DMA_SLAB(A + (size_t)tm * 256 * 1024, BT + (size_t)tn * 256 * 1024, 0, 0);
  }
  WAIT_BAR0();
  for (int tile = blockIdx.x; tile < ntiles; tile += gridDim.x) {
    int tm, tn; tile_map(tile, ntn, tm, tn);
    const int m0 = tm * 256, n0 = tn * 256;
    const int cls = (EPI == 0) ? ((tn >= 6 && tn < 8) ? 1 : (tn >= 8 && tn < 10) ? 2 : (tn >= 10 && tn < 12) ? 3 : 0) : 0;
    const bool vtm = cls == 3;
    const int wA = vtm ? (wave & 1) : wm, wB = vtm ? (wave >> 1) : wn;
    const bfu* Ag = A + (size_t)m0 * 1024;
    const bfu* Bg = BT + (size_t)n0 * 1024;
    f32x16 acc[2][4];
#pragma unroll
    for (int i = 0; i < 2; ++i)
#pragma unroll
      for (int j = 0; j < 4; ++j)
#pragma unroll
        for (int e = 0; e < 16; ++e) acc[i][j][e] = 0.f;
    const bfu* An = Ag; const bfu* Bn = Bg;
    {
      const int nt_ = tile + gridDim.x;
      if (nt_ < ntiles) { int tm2, tn2; tile_map(nt_, ntn, tm2, tn2); An = A + (size_t)tm2 * 256 * 1024; Bn = BT + (size_t)tn2 * 256 * 1024; }
    }
    for (int kt = 0; kt < 16; ++kt) {
      if (kt == 0) asm volatile("s_waitcnt lgkmcnt(0)\n\ts_barrier" ::: "memory"); else WAIT_BAR0();
      const unsigned so = (kt & 1) * 65536;
      const bool dnext = (kt + 1 < 16) || (tile + (int)gridDim.x < ntiles);
      const bfu* dA = (kt + 1 < 16) ? Ag : An; const bfu* dB = (kt + 1 < 16) ? Bg : Bn;
      const int dk = (kt + 1 < 16) ? kt + 1 : 0; const unsigned dso = (kt + 1 < 16) ? 65536 - so : 0;
      const char* sb = lds + so;
      const char* pa = sb + (vtm ? 32768 + (wB * 64 + r) * 128 : (wA * 64 + r) * 128);
      const char* pb = sb + (vtm ? (wA * 128 + r) * 128 : 32768 + (wB * 128 + r) * 128);
      bf16x8 af[2][2], bfr[2][4];
      {
        const unsigned co = (unsigned)((h ^ swz) << 4);
        af[0][0] = *(const bf16x8*)(pa + co); af[0][1] = *(const bf16x8*)(pa + 4096 + co);
#pragma unroll
        for (int j = 0; j < 4; ++j) bfr[0][j] = *(const bf16x8*)(pb + j * 4096 + co);
      }
#pragma unroll
      for (int s = 0; s < 4; ++s) {
        if (s < 3) {
          const unsigned co = (unsigned)((((s + 1) * 2 + h) ^ swz) << 4);
          af[(s + 1) & 1][0] = *(const bf16x8*)(pa + co); af[(s + 1) & 1][1] = *(const bf16x8*)(pa + 4096 + co);
#pragma unroll
          for (int j = 0; j < 4; ++j) bfr[(s + 1) & 1][j] = *(const bf16x8*)(pb + j * 4096 + co);
        }
        SBAR();
#pragma unroll
        for (int i = 0; i < 2; ++i)
#pragma unroll
          for (int j = 0; j < 4; ++j) {
            acc[i][j] = MFMA32(bfr[s & 1][j], af[s & 1][i], acc[i][j]);
            if (s < 2 && (j & 1) && dnext) DMA_PIECE(dA, dB, dk, dso, s * 4 + i * 2 + (j >> 1));
          }
        SBAR();
      }
    }
    WAIT_BAR0();
    if (EPI == 0) {
      char* stg = lds + 65536 + wave * 9216;
#pragma unroll
      for (int jp = 0; jp < 2; ++jp) {
        if (cls == 1 || cls == 2) {
          const float* gg = (cls == 1 ? p.qn_g : p.kn_g) + l * 64;
          const float post = (cls == 1) ? 0.125f * LOG2E : 1.f;
#pragma unroll
          for (int i = 0; i < 2; ++i) {
            float ss = 0.f;
#pragma unroll
            for (int j2 = 0; j2 < 2; ++j2)
#pragma unroll
              for (int e = 0; e < 16; ++e) ss += acc[i][2 * jp + j2][e] * acc[i][2 * jp + j2][e];
            ss += __shfl_xor(ss, 32);
            const float rs = rsqrtf(ss * (1.f / 64.f) + EPS) * post;
#pragma unroll
            for (int j2 = 0; j2 < 2; ++j2)
#pragma unroll
              for (int g = 0; g < 4; ++g) {
                const float4 gv = *(const float4*)(gg + j2 * 32 + 8 * g + 4 * h);
                f32x16& a = acc[i][2 * jp + j2];
                a[4 * g] *= rs * gv.x; a[4 * g + 1] *= rs * gv.y; a[4 * g + 2] *= rs * gv.z; a[4 * g + 3] *= rs * gv.w;
              }
          }
        }
        if (jp) WSYNC();
#pragma unroll
        for (int i = 0; i < 2; ++i)
#pragma unroll
          for (int j2 = 0; j2 < 2; ++j2)
#pragma unroll
            for (int g = 0; g < 4; ++g) {
              const f32x16& a = acc[i][2 * jp + j2];
              uint2 o; o.x = cvtpk(a[4 * g], a[4 * g + 1]); o.y = cvtpk(a[4 * g + 2], a[4 * g + 3]);
              *(uint2*)(stg + (i * 32 + r) * 144 + (j2 * 32 + 8 * g + 4 * h) * 2) = o;
            }
        WSYNC();
        const int nc0 = n0 + wn * 128 + jp * 64;
        bfu* dst; size_t pitch;
        if (cls == 0) { dst = (bfu*)(p.ws + WS_PROJ) + (size_t)(m0 + wm * 64) * NP + nc0; pitch = NP; }
        else if (cls == 3) {
          const int col0 = n0 + wB * 64 - C_DV, bh = (m0 >> 14) * 4 + (col0 >> 7);
          dst = (bfu*)(p.ws + WS_VT) + ((size_t)bh * 128 + (col0 & 127)) * SEQ + ((m0 + wA * 128 + jp * 64) & (SEQ - 1)); pitch = SEQ;
        } else {
          const int col0 = nc0 - (cls == 1 ? C_DQ : C_DK), bh = (m0 >> 14) * 4 + (col0 >> 7);
          dst = (bfu*)(p.ws + (cls == 1 ? WS_QN : WS_KN)) + ((size_t)bh * SEQ + ((m0 + wm * 64) & (SEQ - 1))) * 128 + ((col0 >> 6) & 1) * 64; pitch = 128;
        }
#pragma unroll
        for (int it = 0; it < 8; ++it) {
          const int id = it * 64 + lane, row = id >> 3, c = id & 7;
          const uint4 v = *(const uint4*)(stg + row * 144 + c * 16);
          *(uint4*)(dst + (size_t)row * pitch + c * 8) = v;
        }
      }
    } else {
      char* stg = lds + 65536 + wave * 8704;
      const float* gate = (const float*)(p.ws + WS_MOD) + l * 6144 + (m0 >> 14) * 3072 + 2048;
      float4 xn[8];
#define LOADX(ps_) do { _Pragma("unroll") for (int it = 0; it < 8; ++it) { const int id = it * 64 + lane, row = id >> 4, c = id & 15; \
          xn[it] = *(const float4*)(xin + (size_t)(m0 + wm * 64 + ((ps_) >> 1) * 32 + row) * 1024 + n0 + wn * 128 + ((ps_) & 1) * 64 + c * 4); } } while (0)
      LOADX(0);
#pragma unroll
      for (int ps = 0; ps < 4; ++ps) {
        const int i = ps >> 1, jp = ps & 1;
        float4 xc[8];
#pragma unroll
        for (int it = 0; it < 8; ++it) xc[it] = xn[it];
        if (ps + 1 < 4) LOADX(ps + 1);
        if (ps) WSYNC();
#pragma unroll
        for (int j2 = 0; j2 < 2; ++j2)
#pragma unroll
          for (int g = 0; g < 4; ++g) {
            const f32x16& a = acc[i][2 * jp + j2];
            float4 o; o.x = a[4 * g]; o.y = a[4 * g + 1]; o.z = a[4 * g + 2]; o.w = a[4 * g + 3];
            *(float4*)(stg + r * 272 + (j2 * 32 + 8 * g + 4 * h) * 4) = o;
          }
        WSYNC();
#pragma unroll
        for (int it = 0; it < 8; ++it) {
          const int id = it * 64 + lane, row = id >> 4, c = id & 15;
          const float4 y = *(const float4*)(stg + row * 272 + c * 16);
          const int m = m0 + wm * 64 + i * 32 + row, n = n0 + wn * 128 + jp * 64 + c * 4;
          const float4 xv = xc[it];
          const float4 gv = *(const float4*)(gate + n);
          float4 o; o.x = xv.x + gv.x * y.x; o.y = xv.y + gv.y * y.y; o.z = xv.z + gv.z * y.z; o.w = xv.w + gv.w * y.w;
          *(float4*)(p.out + (size_t)m * 1024 + n) = o;
        }
      }
#undef LOADX
    }
  }
#undef DMA_SLAB
#undef DMA_PIECE
#undef SBAR
#undef WSYNC
  if (EPI == 0) {
    using f32x4 = __attribute__((ext_vector_type(4))) float;
    bfu* proj = (bfu*)(p.ws + WS_PROJ);
    const int quad = lane >> 4, c16 = lane & 15;
    const bfu* wrow = BT + (size_t)(C_GLR + c16) * 1024 + quad * 8;
    for (int rb = blockIdx.x * 8 + wave; rb < T / 16; rb += gridDim.x * 8) {
      const bfu* hrow = A + (size_t)(rb * 16 + c16) * 1024 + quad * 8;
      f32x4 c4 = {0.f, 0.f, 0.f, 0.f};
#pragma unroll 8
      for (int ks = 0; ks < 32; ++ks) {
        const bf16x8 wf = *(const bf16x8*)(wrow + ks * 32);
        const bf16x8 hf = *(const bf16x8*)(hrow + ks * 32);
        c4 = __builtin_amdgcn_mfma_f32_16x16x32_bf16(wf, hf, c4, 0, 0, 0);
      }
      uint2 o; o.x = cvtpk(c4[0], c4[1]); o.y = cvtpk(c4[2], c4[3]);
      *(uint2*)(proj + (size_t)(rb * 16 + c16) * NP + C_GLR + quad * 4) = o;
    }
  }
}

DI void prep_gla_load(const Params& p, int b, int c, int hh, uint4& v0, uint4& v1, uint4& v2, uint4& v3, uint4& v4) {
  const int tid = opaque_tid();
  const bfu* proj = (const bfu*)(p.ws + WS_PROJ);
  const int row0 = b * SEQ + c * 64;
#define PGL(i, vi) do { const int id = (i) * NT + tid; vi = make_uint4(0u, 0u, 0u, 0u); \
    if (id < 2144) { const int row = id >> 5, ch = id & 31; \
      const int col = ch < 8 ? (C_GQ + hh * 64 + ch * 8) : (ch < 16 ? (C_GK + hh * 64 + (ch - 8) * 8) : (C_GV + hh * 128 + (ch - 16) * 8)); \
      if (c > 0 || row >= 3) vi = *(const uint4*)(proj + (size_t)(row0 + row - 3) * NP + col); } \
    else if (id < 2272) { const int id2 = id - 2144; vi = *(const uint4*)(proj + (size_t)(row0 + (id2 >> 1)) * NP + C_GLR + (id2 & 1) * 8); } } while (0)
  PGL(0, v0); PGL(1, v1); PGL(2, v2); PGL(3, v3); PGL(4, v4);
#undef PGL
}
DI void prep_gla_item(const Params& p, char* lds, int l, int b, int c, int hh, const uint4& v0, const uint4& v1, const uint4& v2, const uint4& v3, const uint4& v4, int nb, int nc, int nh, bool has_next,
                      uint4& n0, uint4& n1, uint4& n2, uint4& n3, uint4& n4) {
  const int tid = opaque_tid(), lane = tid & 63, r = lane & 31, h = lane >> 5;
  const int wave = __builtin_amdgcn_readfirstlane(tid >> 6);
  char* X = lds;
  char* G = lds + 35376;
  float* kf = (float*)(lds + 37424);
  char* vT = lds + 54832;
  char* kdT = lds + 71216;
  float* tot = (float*)(lds + 79408);
  char* Qs = lds + 81456;
  const bfu* proj = (const bfu*)(p.ws + WS_PROJ);
  bfu* qs = (bfu*)(p.ws + WS_QS); bfu* ub = (bfu*)(p.ws + WS_U); float* ab = (float*)(p.ws + WS_A);
  const int row0 = b * SEQ + c * 64;
  {
#define PGS(i, vi) do { const int id = (i) * NT + tid; if (id < 2144) *(uint4*)(X + (id >> 5) * 528 + (id & 31) * 16) = vi; else if (id < 2272) *(uint4*)(G + (id - 2144) * 16) = vi; } while (0)
    PGS(0, v0); PGS(1, v1); PGS(2, v2); PGS(3, v3); PGS(4, v4);
#undef PGS
  }
  if (has_next) prep_gla_load(p, nb, nc, nh, n0, n1, n2, n3, n4);
  __syncthreads();
  {
    const int j = tid & 255, half = tid >> 8;
    const int col = j < 64 ? (C_GQ + hh * 64 + j) : (j < 128 ? (C_GK + hh * 64 + (j - 64)) : (C_GV + hh * 128 + (j - 128)));
    const float* cw = p.conv_w + (size_t)l * 4 * 1024 + col;
    const float w0 = cw[0], w1 = cw[1024], w2 = cw[2048], w3 = cw[3072];
    const int t0 = half * 32;
    const char* xs = X + t0 * 528 + j * 2;
    float x0 = bf2f(*(const bfu*)(xs)), x1 = bf2f(*(const bfu*)(xs + 528)), x2 = bf2f(*(const bfu*)(xs + 1056));
    float y[32];
#pragma unroll
    for (int tt = 0; tt < 32; ++tt) {
      const float xt = bf2f(*(const bfu*)(xs + (tt + 3) * 528));
      y[tt] = silu_f(w0 * x0 + w1 * x1 + w2 * x2 + w3 * xt);
      x0 = x1; x1 = x2; x2 = xt;
    }
    const int role = __builtin_amdgcn_readfirstlane(j >> 6);
    if (role == 0) {
#pragma unroll
      for (int tt = 0; tt < 32; ++tt) *(bfu*)(Qs + (t0 + tt) * 128 + j * 2) = f2bf(y[tt] * 0.125f);
    } else if (role == 1) {
      float* kr = kf + (j - 64) * 68 + t0;
#pragma unroll
      for (int q4 = 0; q4 < 8; ++q4) { float4 o; o.x = y[4 * q4]; o.y = y[4 * q4 + 1]; o.z = y[4 * q4 + 2]; o.w = y[4 * q4 + 3]; *(float4*)(kr + 4 * q4) = o; }
    } else {
      const int dv = j - 128;
#pragma unroll
      for (int cc = 0; cc < 4; ++cc) {
        uint4 o; o.x = cvtpk(y[8 * cc], y[8 * cc + 1]); o.y = cvtpk(y[8 * cc + 2], y[8 * cc + 3]); o.z = cvtpk(y[8 * cc + 4], y[8 * cc + 5]); o.w = cvtpk(y[8 * cc + 6], y[8 * cc + 7]);
        *(uint4*)(vT + dv * 128 + ((((t0 >> 3) + cc) ^ ((dv >> 1) & 7)) << 4)) = o;
      }
    }
  }
  __syncthreads();
  {
    const int dk = tid & 63, tg = wave;
    float wg[16];
#pragma unroll
    for (int q = 0; q < 16; ++q) wg[q] = p.w_gk[(size_t)(l * 16 + q) * 256 + hh * 64 + dk];
    const float bias = p.b_gk[l * 256 + hh * 64 + dk];
    float cs[8]; float cum = 0.f;
#pragma unroll
    for (int i = 0; i < 8; ++i) {
      const int t = tg * 8 + i;
      const uint4* gp = (const uint4*)(G + t * 32);
      const uint4 g0 = gp[0], g1 = gp[1];
      const unsigned gw[8] = {g0.x, g0.y, g0.z, g0.w, g1.x, g1.y, g1.z, g1.w};
      float z = bias;
#pragma unroll
      for (int q = 0; q < 8; ++q) { z += bf2f(gw[q] & 0xffffu) * wg[2 * q]; z += __uint_as_float(gw[q] & 0xffff0000u) * wg[2 * q + 1]; }
      const float ls = fminf(z, 0.f) - __logf(1.f + __expf(-fabsf(z)));
      cum += ls * (1.f / 16.f);
      cs[i] = cum;
    }
    tot[tg * 64 + dk] = cum;
    __syncthreads();
    float off = 0.f, total = 0.f;
#pragma unroll
    for (int g = 0; g < 8; ++g) { const float tv = tot[g * 64 + dk]; total += tv; if (g < tg) off += tv; }
    float kd[8];
    {
      const float4 ka = *(const float4*)(kf + dk * 68 + tg * 8), kb2 = *(const float4*)(kf + dk * 68 + tg * 8 + 4);
      const float kv[8] = {ka.x, ka.y, ka.z, ka.w, kb2.x, kb2.y, kb2.z, kb2.w};
#pragma unroll
      for (int i = 0; i < 8; ++i) kd[i] = kv[i] * __expf(total - (off + cs[i]));
    }
    {
      const int t = tid >> 3, c = tid & 7;
      *(uint4*)(qs + (size_t)(row0 + t) * 256 + hh * 64 + c * 8) = *(const uint4*)(Qs + t * 128 + c * 16);
    }
    uint4 o; o.x = cvtpk(kd[0], kd[1]); o.y = cvtpk(kd[2], kd[3]); o.z = cvtpk(kd[4], kd[5]); o.w = cvtpk(kd[6], kd[7]);
    *(uint4*)(kdT + dk * 128 + ((tg ^ ((dk >> 1) & 7)) << 4)) = o;
    if (tg == 0) ab[(size_t)(b * NCH + c) * 256 + hh * 64 + dk] = __expf(total);
  }
  __syncthreads();
  {
    const int dvb = wave >> 1, dkb = wave & 1;
    f32x16 acc;
#pragma unroll
    for (int e = 0; e < 16; ++e) acc[e] = 0.f;
    const int swz = (r >> 1) & 7;
#pragma unroll
    for (int s = 0; s < 4; ++s) {
      const unsigned co = (unsigned)(((s * 2 + h) ^ swz) << 4);
      const bf16x8 a = *(const bf16x8*)(vT + (dvb * 32 + r) * 128 + co);
      const bf16x8 bb = *(const bf16x8*)(kdT + (dkb * 32 + r) * 128 + co);
      acc = MFMA32(a, bb, acc);
    }
    bfu* up = ub + (size_t)((b * NCH + c) * 4 + hh) * 8192 + dkb * 32 + r;
#pragma unroll
    for (int e = 0; e < 16; ++e) up[(dvb * 32 + crow(e, h)) * 64] = f2bf(acc[e]);
  }
  __syncthreads();
}

DI void phase_prep(const Params& p, char* lds, int l) {
  constexpr int NIT = BATCH * NCH * 4;
  uint4 a0, a1, a2, a3, a4, b0, b1, b2, b3, b4;
  int it = blockIdx.x;
  if (it < NIT) prep_gla_load(p, (it & 511) >> 8, it & 255, it >> 9, a0, a1, a2, a3, a4);
  for (; it < NIT; it += gridDim.x) {
    const int ty = it >> 9, ch = it & 511, b = ch >> 8, c = ch & 255;
    const int nx = it + gridDim.x; const bool hn = nx < NIT;
    prep_gla_item(p, lds, l, b, c, ty, a0, a1, a2, a3, a4, (nx & 511) >> 8, nx & 255, nx >> 9, hn, b0, b1, b2, b3, b4);
    a0 = b0; a1 = b1; a2 = b2; a3 = b3; a4 = b4;
  }
}

#define XB_TMO      128
#define XB_XCNT(j)  (256  + 64 * (j))
#define XB_XSUB(j)  (1280 + 64 * (j))
#define XB_XGEN(j)  (2304 + 64 * (j))
#define XB_TOP      3328
#define XB_TOPGEN   3392
#define XCD_BAR_WORDS 3456
#define XB_SPIN_CAP (1u << 18)
DI unsigned xb_ld(unsigned* p) { return __hip_atomic_load(p, __ATOMIC_RELAXED, __HIP_MEMORY_SCOPE_AGENT); }
DI unsigned xb_add(unsigned* p, unsigned v) { return __hip_atomic_fetch_add(p, v, __ATOMIC_RELAXED, __HIP_MEMORY_SCOPE_AGENT); }
DI unsigned xb_xcc_id() { return (unsigned)__builtin_amdgcn_s_getreg((3 << 11) | 20) & 0xFu; }
#define XB_SPIN(cond, bar) do { unsigned _sp = 0; while (cond) { __builtin_amdgcn_s_sleep(1); \
    if ((++_sp & 255u) == 0u) { if (xb_ld(&(bar)[XB_TMO])) break; if (_sp > XB_SPIN_CAP) { atomicAdd(&(bar)[XB_TMO], 1u); break; } } } } while (0)
struct XcdBarrier { unsigned* bar; unsigned x; };
DI XcdBarrier xcd_barrier_post(unsigned* bar) {
  XcdBarrier b; b.bar = bar; b.x = xb_xcc_id();
  if (threadIdx.x == 0) (void)xb_add(&bar[XB_XCNT(b.x)], 1u);
  return b;
}
DI void xcd_barrier_complete(unsigned* bar, unsigned x, unsigned& nloc, unsigned& nx) {
  const unsigned G = gridDim.x * gridDim.y * gridDim.z;
  unsigned sum, cnt, mine, sp = 0u;
  for (;;) {
    sum = 0u; cnt = 0u; mine = 0u;
#pragma unroll
    for (unsigned j = 0; j < 16; ++j) { const unsigned c = xb_ld(&bar[XB_XCNT(j)]); sum += c; cnt += (c > 0u) ? 1u : 0u; mine = (j == x) ? c : mine; }
    if (sum == G) break;
    __builtin_amdgcn_s_sleep(1);
    if ((++sp & 255u) == 0u) { if (xb_ld(&bar[XB_TMO])) break; if (sp > XB_SPIN_CAP) { atomicAdd(&bar[XB_TMO], 1u); break; } }
  }
  nloc = mine > 0u ? mine : 1u; nx = cnt > 0u ? cnt : 1u;
}
DI void xcd_barrier(const XcdBarrier& b, volatile unsigned* st) {
  asm volatile("s_waitcnt vmcnt(0)" ::: "memory");
  __syncthreads();
  if (threadIdx.x == 0) {
    unsigned* bar = b.bar;
    const unsigned bx = xb_xcc_id();
    __builtin_amdgcn_s_waitcnt(0);
    unsigned nloc = st[0], nx = st[1];
    if (nloc == 0u) { xcd_barrier_complete(bar, bx, nloc, nx); st[0] = nloc; st[1] = nx; }
    const unsigned old = xb_add(&bar[XB_XSUB(bx)], 1u);
    const unsigned gen = old / nloc;
    if (old + 1u == (gen + 1u) * nloc) {
      __builtin_amdgcn_fence(__ATOMIC_RELEASE, "agent");
      asm volatile("s_waitcnt vmcnt(0)" ::: "memory");
      const unsigned og = xb_add(&bar[XB_TOP], 1u);
      const unsigned tg = og / nx;
      if (og + 1u == (tg + 1u) * nx) xb_add(&bar[XB_TOPGEN], 1u);
      else XB_SPIN(xb_ld(&bar[XB_TOPGEN]) == tg, bar);
      __builtin_amdgcn_fence(__ATOMIC_ACQUIRE, "agent");
      xb_add(&bar[XB_XGEN(bx)], 1u);
      asm volatile("s_waitcnt vmcnt(0)" ::: "memory");
    } else {
      XB_SPIN(xb_ld(&bar[XB_XGEN(bx)]) == gen, bar);
      __builtin_amdgcn_fence(__ATOMIC_ACQUIRE, "agent");
      asm volatile("s_waitcnt vmcnt(0)" ::: "memory");
    }
  }
  __syncthreads();
}

DI void phase_ogla(const Params& p, char* lds, int l) {
  const int tid = opaque_tid(), lane = tid & 63, r = lane & 31, h = lane >> 5;
  const int wave = __builtin_amdgcn_readfirstlane(tid >> 6), hh = wave >> 1, tb = wave & 1;
  const bfu* qs = (const bfu*)(p.ws + WS_QS); const bfu* ub = (const bfu*)(p.ws + WS_U);
  const bfu* proj = (const bfu*)(p.ws + WS_PROJ); bfu* mix = (bfu*)(p.ws + WS_H);
  const float* gg = p.gla_g + l * 128;
  for (int it = blockIdx.x; it < BATCH * NCH; it += gridDim.x) {
    const int b = it >> 8, c = it & 255;
    const size_t row = (size_t)b * SEQ + c * 64 + tb * 32 + r;
    bf16x8 qf[4];
#pragma unroll
    for (int ks = 0; ks < 4; ++ks) qf[ks] = *(const bf16x8*)(qs + row * 256 + hh * 64 + ks * 16 + h * 8);
    uint2 zq[16];
    {
      const size_t rowz = (size_t)b * SEQ + c * 64 + tb * 32;
#pragma unroll
      for (int it2 = 0; it2 < 16; ++it2) { const int id = it2 * 64 + lane; zq[it2] = *(const uint2*)(proj + (rowz + (id >> 5)) * NP + C_GZ + hh * 128 + (id & 31) * 4); }
    }
    const bfu* sp = ub + (size_t)((b * NCH + c) * 4 + hh) * 8192;
    f32x16 O[4];
#pragma unroll
    for (int d = 0; d < 4; ++d)
#pragma unroll
      for (int e = 0; e < 16; ++e) O[d][e] = 0.f;
#pragma unroll
    for (int ks = 0; ks < 4; ++ks)
#pragma unroll
      for (int d = 0; d < 4; ++d) {
        const bf16x8 sf = *(const bf16x8*)(sp + (d * 32 + r) * 64 + ks * 16 + h * 8);
        O[d] = MFMA32(sf, qf[ks], O[d]);
      }
    float ss = 0.f;
#pragma unroll
    for (int d = 0; d < 4; ++d)
#pragma unroll
      for (int e = 0; e < 16; ++e) ss += O[d][e] * O[d][e];
    ss += __shfl_xor(ss, 32);
    const float rstd = rsqrtf(ss * (1.f / 128.f) + EPS);
    char* stg = lds + wave * 16896;
    asm volatile("s_waitcnt lgkmcnt(0)" ::: "memory");
#pragma unroll
    for (int d = 0; d < 4; ++d)
#pragma unroll
      for (int g = 0; g < 4; ++g) {
        float4 o; o.x = O[d][4 * g] * rstd; o.y = O[d][4 * g + 1] * rstd; o.z = O[d][4 * g + 2] * rstd; o.w = O[d][4 * g + 3] * rstd;
        *(float4*)(stg + r * 528 + (d * 32 + 8 * g + 4 * h) * 4) = o;
      }
    asm volatile("s_waitcnt lgkmcnt(0)" ::: "memory");
    const size_t row0 = (size_t)b * SEQ + c * 64 + tb * 32;
#pragma unroll
    for (int it2 = 0; it2 < 16; ++it2) {
      const int id = it2 * 64 + lane, rr = id >> 5, cc = id & 31;
      const float4 v = *(const float4*)(stg + rr * 528 + cc * 16);
      const uint2 zr = zq[it2];
      const float4 gv = *(const float4*)(gg + cc * 4);
      const float z0 = bf2f(zr.x & 0xffffu), z1 = __uint_as_float(zr.x & 0xffff0000u), z2 = bf2f(zr.y & 0xffffu), z3 = __uint_as_float(zr.y & 0xffff0000u);
      uint2 o;
      o.x = cvtpk(v.x * gv.x * silu_f(z0), v.y * gv.y * silu_f(z1));
      o.y = cvtpk(v.z * gv.z * silu_f(z2), v.w * gv.w * silu_f(z3));
      *(uint2*)(mix + (row0 + rr) * 1024 + hh * 128 + cc * 4) = o;
    }
  }
}

DI void scan_items(const Params& p) {
  const int tid = opaque_tid();
  bfu* ub = (bfu*)(p.ws + WS_U); const float* ab = (const float*)(p.ws + WS_A);
  if (tid < 256) {
    for (int it = blockIdx.x; it < 256; it += gridDim.x) {
      const int e = it * 256 + tid, b = e >> 15, rem = e & 32767, hh = rem >> 13, dk = rem & 63;
      bfu* up = ub + (size_t)b * NCH * 32768 + rem;
      const float* ap = ab + (size_t)b * NCH * 256 + hh * 64 + dk;
      float st = 0.f;
      for (int c0 = 0; c0 < NCH; c0 += 32) {
        bfu uv[32]; float av[32];
#pragma unroll
        for (int i = 0; i < 32; ++i) { uv[i] = up[(size_t)(c0 + i) * 32768]; av[i] = ap[(c0 + i) * 256]; }
#pragma unroll
        for (int i = 0; i < 32; ++i) { st = av[i] * st + bf2f(uv[i]); up[(size_t)(c0 + i) * 32768] = f2bf(st); }
      }
    }
  }
}

DI void attn_item(const Params& p, char* lds, int l, int bh, int jt, float lam, float outscale) {
  const int tid = opaque_tid(), lane = tid & 63, r = lane & 31, h = lane >> 5;
  const int wave = __builtin_amdgcn_readfirstlane(tid >> 6);
  const bfu* Kg = (const bfu*)(p.ws + WS_KN) + (size_t)bh * SEQ * 128;
  const bfu* Qg = (const bfu*)(p.ws + WS_QN) + (size_t)bh * SEQ * 128;
  const bfu* Vg = (const bfu*)(p.ws + WS_VT) + (size_t)bh * 128 * SEQ;
  const int nkt = 4 * jt + 4, my_last = 4 * jt + (wave >> 1);
  const int qrow = jt * 256 + wave * 32 + r;
  const int krow_l = 4 * wave + (lane >> 4), kp = lane & 15;
  const bfu* kgp = Kg + (size_t)krow_l * 128 + ((kp ^ (krow_l & 15)) * 8);
  const int vrow_l = 8 * wave + (lane >> 3), vp = lane & 7;
  const bfu* vgp = Vg + (size_t)vrow_l * SEQ + ((vp ^ ((vrow_l >> 1) & 7)) * 8);
  const unsigned lds0 = (unsigned)(uintptr_t)lds;
  const unsigned dk0 = (unsigned)__builtin_amdgcn_readfirstlane(lds0 + wave * 1024);
#define DMA_TILE(kt_, so_) do { glds16(kgp + (size_t)(kt_) * 64 * 128, dk0 + (so_)); glds16(kgp + (size_t)(kt_) * 64 * 128 + 32 * 128, dk0 + (so_) + 8192); \
    glds16(vgp + (kt_) * 64, dk0 + (so_) + 16384); glds16(vgp + (size_t)64 * SEQ + (kt_) * 64, dk0 + (so_) + 24576); } while (0)
  WAIT_BAR0();
  DMA_TILE(0, 0);
  char* q1s = lds + 65536 + tid * 16;
#pragma unroll
  for (int ks = 0; ks < 4; ++ks) {
    *(bf16x8*)(q1s + 32768 + ks * 8192) = *(const bf16x8*)(Qg + (size_t)qrow * 128 + ks * 16 + h * 8);
    *(bf16x8*)(q1s + ks * 8192) = *(const bf16x8*)(Qg + (size_t)qrow * 128 + 64 + ks * 16 + h * 8);
  }
  f32x16 O0[4], O1[4];
#pragma unroll
  for (int d = 0; d < 4; ++d)
#pragma unroll
    for (int e = 0; e < 16; ++e) { O0[d][e] = 0.f; O1[d][e] = 0.f; }
  float l0 = 0.f, l1 = 0.f;
  const int pr = pi_row(r);
  const unsigned kb = pr * 256 + (((pr & 15) ^ h) << 4);
  const unsigned vb = 16384 + r * 128 + ((((r >> 1) & 7) ^ h) << 4);
  for (int kt = 0; kt < nkt; ++kt) {
    WAIT_BAR0();
    const unsigned so = (kt & 1) * 32768;
    if (kt + 1 < nkt) DMA_TILE(kt + 1, 32768 - so);
    if (kt <= my_last) {
#define KFRAG(sub_, mp_, ks_) (*(const bf16x8*)(lds + ((kb + so + (sub_) * 8192) ^ (unsigned)((((mp_) * 8) + (ks_) * 2) << 4))))
#define VFRAG(sub_, d_, s_) (*(const bf16x8*)(lds + ((vb + so + (d_) * 4096) ^ (unsigned)(((sub_) * 4 + (s_) * 2) << 4))))
#define QFRAG(mp_, ks_) (*(const bf16x8*)(q1s + ((mp_) ? 0 : 32768) + (ks_) * 8192))
#define SOFTMAX_PACK(S_, P_, l_) do { _Pragma("unroll") for (int e = 0; e < 16; ++e) { S_[e] = __builtin_amdgcn_exp2f(S_[e]); l_ += S_[e]; } \
        _Pragma("unroll") for (int s = 0; s < 2; ++s) { u32x4 a_; _Pragma("unroll") for (int q = 0; q < 4; ++q) a_[q] = cvtpk(S_[8 * s + 2 * q], S_[8 * s + 2 * q + 1]); P_[s] = __builtin_bit_cast(bf16x8, a_); } } while (0)
      bf16x8 pa0[2], pa1[2];
      f32x16 S0, S1;
#pragma unroll
      for (int e = 0; e < 16; ++e) { S0[e] = 0.f; S1[e] = 0.f; }
#pragma unroll
      for (int ks = 0; ks < 4; ++ks) {
        S0 = MFMA32(KFRAG(0, 0, ks), QFRAG(0, ks), S0);
        S1 = MFMA32(KFRAG(0, 1, ks), QFRAG(1, ks), S1);
      }
      SOFTMAX_PACK(S0, pa0, l0);
      SOFTMAX_PACK(S1, pa1, l1);
#pragma unroll
      for (int e = 0; e < 16; ++e) { S0[e] = 0.f; S1[e] = 0.f; }
#pragma unroll
      for (int ks = 0; ks < 4; ++ks) {
        S0 = MFMA32(KFRAG(1, 0, ks), QFRAG(0, ks), S0);
        S1 = MFMA32(KFRAG(1, 1, ks), QFRAG(1, ks), S1);
#pragma unroll
        for (int dd = 0; dd < 2; ++dd) {
          const int d = (ks & 1) * 2 + dd, s = ks >> 1;
          const bf16x8 vf = VFRAG(0, d, s);
          O0[d] = MFMA32(vf, pa0[s], O0[d]);
          O1[d] = MFMA32(vf, pa1[s], O1[d]);
        }
      }
      bf16x8 pc0[2], pc1[2];
      SOFTMAX_PACK(S0, pc0, l0);
      SOFTMAX_PACK(S1, pc1, l1);
#pragma unroll
      for (int s = 0; s < 2; ++s) {
#pragma unroll
        for (int d = 0; d < 4; ++d) {
          const bf16x8 vf = VFRAG(1, d, s);
          O0[d] = MFMA32(vf, pc0[s], O0[d]);
          O1[d] = MFMA32(vf, pc1[s], O1[d]);
        }
      }
#undef KFRAG
#undef VFRAG
#undef QFRAG
#undef SOFTMAX_PACK
    }
  }
#undef DMA_TILE
  l0 += __shfl_xor(l0, 32); l1 += __shfl_xor(l1, 32);
  const float i0 = 1.f / l0, i1 = -lam / l1;
  float ss = 0.f;
#pragma unroll
  for (int d = 0; d < 4; ++d)
#pragma unroll
    for (int e = 0; e < 16; ++e) { const float o = O0[d][e] * i0 + O1[d][e] * i1; O0[d][e] = o; ss += o * o; }
  ss += __shfl_xor(ss, 32);
  const float rstd = rsqrtf(ss * (1.f / 128.f) + EPS) * outscale;
  const int b = bh >> 2, hh = bh & 3;
  const size_t row = (size_t)b * SEQ + qrow;
  const bfu* zp = (const bfu*)(p.ws + WS_PROJ) + row * NP + C_DZ + hh * 128;
  bfu* mp = (bfu*)(p.ws + WS_H) + row * 1024 + 512 + hh * 128;
  const float* gd = p.diff_g + l * 128;
#pragma unroll
  for (int d = 0; d < 4; ++d)
#pragma unroll
    for (int g = 0; g < 4; ++g) {
      const int dv = d * 32 + 8 * g + 4 * h;
      const uint2 zr = *(const uint2*)(zp + dv);
      const float4 gv = *(const float4*)(gd + dv);
      const float z0 = bf2f(zr.x & 0xffffu), z1 = __uint_as_float(zr.x & 0xffff0000u), z2 = bf2f(zr.y & 0xffffu), z3 = __uint_as_float(zr.y & 0xffff0000u);
      uint2 o;
      o.x = cvtpk(O0[d][4 * g] * rstd * gv.x * silu_f(z0), O0[d][4 * g + 1] * rstd * gv.y * silu_f(z1));
      o.y = cvtpk(O0[d][4 * g + 2] * rstd * gv.z * silu_f(z2), O0[d][4 * g + 3] * rstd * gv.w * silu_f(z3));
      *(uint2*)(mp + dv) = o;
    }
}

DI void phase_attn(const Params& p, char* lds, int l) {
  scan_items(p);
  const float lam = ((const float*)(p.ws + WS_LAM))[l];
  const float outscale = 1.f - p.lam_init[l];
  unsigned* scnt = (unsigned*)(p.ws + WS_BAR) + 3584;
  asm volatile("s_waitcnt vmcnt(0)" ::: "memory");
  __syncthreads();
  if (threadIdx.x == 0) {
    __builtin_amdgcn_fence(__ATOMIC_RELEASE, "agent");
    asm volatile("s_waitcnt vmcnt(0)" ::: "memory");
    (void)xb_add(scnt, 1u);
  }
  if (__builtin_amdgcn_readfirstlane(threadIdx.x) >= 256) __builtin_amdgcn_s_setprio(1);
  for (int pr = blockIdx.x; pr < 256; pr += gridDim.x) {
    const int bh = pr & 7, jj = pr >> 3;
#pragma unroll 1
    for (int rep = 0; rep < 2; ++rep) attn_item(p, lds, l, bh, rep ? jj : 63 - jj, lam, outscale);
  }
  __builtin_amdgcn_s_setprio(0);
  if (threadIdx.x == 0) {
    const unsigned target = gridDim.x * (unsigned)(l + 1);
    unsigned sp = 0;
    while (xb_ld(scnt) < target) { __builtin_amdgcn_s_sleep(1); if (++sp > (1u << 22)) break; }
    __builtin_amdgcn_fence(__ATOMIC_ACQUIRE, "agent");
    asm volatile("s_waitcnt vmcnt(0)" ::: "memory");
  }
  __syncthreads();
  phase_ogla(p, lds, l);
}

__global__ void __launch_bounds__(NT) fwd_megakernel(Params p) {
  extern __shared__ __attribute__((aligned(16))) char lds[];
  cg::grid_group grid = cg::this_grid();
  volatile unsigned* xst = (volatile unsigned*)(lds + LDS_BYTES);
  if (threadIdx.x == 0) { xst[0] = 0u; xst[1] = 0u; }
  __syncthreads();
  const XcdBarrier xbar = xcd_barrier_post((unsigned*)(p.ws + WS_BAR));
#define GBAR() xcd_barrier(xbar, (volatile unsigned*)(lds + LDS_BYTES))
  p0_prologue(p, lds);
  grid.sync();
  {
    const int wv = __builtin_amdgcn_readfirstlane(threadIdx.x >> 6);
#pragma unroll 1
    for (int step = 0; step < 2; ++step) { if ((step ^ wv) & 1) p0_tiles(p, lds); else phase_norm(p, 0, p.x); }
  }
  GBAR();
#pragma unroll 1
  for (int l = 0; l < DEPTH; ++l) {
    const float* xin = (l == 0) ? p.x : p.out;
    if (l > 0) { phase_norm(p, l, xin); GBAR(); }
    gemm_phase<0>(p, lds, (const bfu*)(p.ws + WS_H), (const bfu*)(p.ws + WS_WINT) + (size_t)l * NP * 1024, 14, l, nullptr);
    GBAR();
    phase_prep(p, lds, l);
    GBAR();
    phase_attn(p, lds, l);
    GBAR();
    gemm_phase<1>(p, lds, (const bfu*)(p.ws + WS_H), (const bfu*)(p.ws + WS_WOUTT) + (size_t)l * 1024 * 1024, 4, l, xin);
    if (l + 1 < DEPTH) GBAR();
  }
#undef GBAR
}

#ifndef MK_SPLIT
#define MK_SPLIT 0
#endif

extern "C" void kernel_launch(void* const* d_in, const int* in_sizes, int n_in, void* d_out, int out_size, void* d_ws, size_t ws_size, hipStream_t stream) {
  static int grid_blocks = 0;
  if (!grid_blocks) {
    if (ws_size < WS_END) { fprintf(stderr, "kernel_launch: workspace too small: %zu < %zu\n", ws_size, (size_t)WS_END); grid_blocks = -1; return; }
    int dev = 0, cus = 0, per_cu = 0;
    hipGetDevice(&dev);
    hipDeviceGetAttribute(&cus, hipDeviceAttributeMultiprocessorCount, dev);
    hipFuncSetAttribute((const void*)fwd_megakernel, hipFuncAttributeMaxDynamicSharedMemorySize, LDS_BYTES + 16);
    hipOccupancyMaxActiveBlocksPerMultiprocessor(&per_cu, (const void*)fwd_megakernel, NT, LDS_BYTES + 16);
    if (per_cu < 1) per_cu = 1;
    if (per_cu > 1) per_cu = 1;
    grid_blocks = cus * per_cu;
  }
  if (grid_blocks < 0) return;
  Params p{};
  p.x = (const float*)d_in[0]; p.c = (const float*)d_in[1]; p.w_ada = (const float*)d_in[2]; p.b_ada = (const float*)d_in[3];
  p.norm_g = (const float*)d_in[4]; p.w_in = (const float*)d_in[5]; p.conv_w = (const float*)d_in[6]; p.w_gk = (const float*)d_in[7];
  p.b_gk = (const float*)d_in[8]; p.gla_g = (const float*)d_in[9]; p.qn_g = (const float*)d_in[10]; p.kn_g = (const float*)d_in[11];
  p.lq1 = (const float*)d_in[12]; p.lk1 = (const float*)d_in[13]; p.lq2 = (const float*)d_in[14]; p.lk2 = (const float*)d_in[15];
  p.diff_g = (const float*)d_in[16]; p.w_out = (const float*)d_in[17];
  p.out = (float*)d_out; p.ws = (unsigned char*)d_ws;
  const double li[4] = {0.8 - 0.6 * 1.0, 0.8 - 0.6 * 0.7408182206817179, 0.8 - 0.6 * 0.5488116360940264, 0.8 - 0.6 * 0.4065696597405991};
  for (int l = 0; l < 4; ++l) p.lam_init[l] = (float)li[l];
  hipMemsetAsync((char*)d_ws + WS_BAR, 0, 16384, stream);
  constexpr int NPH = 2 + 6 * DEPTH;
  void* args[] = {&p};
  hipError_t e = hipLaunchCooperativeKernel((void*)fwd_megakernel, dim3(grid_blocks), dim3(NT), args, LDS_BYTES + 16, stream);
  if (e != hipSuccess) fprintf(stderr, "cooperative launch failed: %s (grid %d)\n", hipGetErrorString(e), grid_blocks);
}
```
